# Optimizing an MI355X kernel written in HIP

```python
import math
import jax
import jax.numpy as jnp
from jax import lax
import numpy as np

D_MODEL = 2048
BATCH = 16
SEQ = 2048
DEPTH = 2

HEAD_DIM = 64
SB_HEADS = 8
DIL_PATTERNS = ((128, 1), (512, 4), (2048, 16))
DIL_HEADS_PER_GROUP = 4
DIL_HEADS = DIL_HEADS_PER_GROUP * len(DIL_PATTERNS)
SSM_WIDTH = 512
SSM_GROUP = 16
SSM_GROUPS = SSM_WIDTH // SSM_GROUP
SSM_STATE = 64
DSA_HEADS = 8
IDX_HEADS = 8
IDX_DIM = 64
DSA_TOPK = 256
N_BRANCH = 4
D_FF = 5632
REL_BUCKETS = 32
REL_MAX_DIST = 128
REL_HEADS = DIL_HEADS + DSA_HEADS
Q_BLOCK = 128
DN_ALPHA = (2.0 * DEPTH) ** 0.25
DN_BETA = (8.0 * DEPTH) ** -0.25
LN_EPS = 1e-5
NEG_INF = -1e30
MACARON = 0.5

IN_SPLITS = (3 * SB_HEADS * HEAD_DIM, 3 * DIL_HEADS * HEAD_DIM, SSM_WIDTH, 3 * DSA_HEADS * HEAD_DIM,
             IDX_HEADS * IDX_DIM, IDX_DIM, IDX_HEADS, N_BRANCH * D_MODEL)
IN_COLS = sum(IN_SPLITS)
IN_OFFSETS = tuple(int(o) for o in np.cumsum(IN_SPLITS)[:-1])

kernel_name = "hybrid_gated_mixer_block"


def layer_norm(x, g, b):
    xf = x.astype(jnp.float32)
    mu = jnp.mean(xf, axis=-1, keepdims=True)
    var = jnp.mean(jnp.square(xf - mu), axis=-1, keepdims=True)
    return ((xf - mu) * lax.rsqrt(var + LN_EPS) * g.astype(jnp.float32) + b.astype(jnp.float32)).astype(x.dtype)


def swiglu_ffn(x, w_up, w_down):
    a, b = jnp.split(x @ w_up, 2, axis=-1)
    return (jax.nn.silu(a) * b) @ w_down


def t5_bucket(dist):
    max_exact = REL_BUCKETS // 2
    d = jnp.maximum(dist, 1).astype(jnp.float32)
    large = max_exact + (jnp.log(d / max_exact) / math.log(REL_MAX_DIST / max_exact)
                         * (REL_BUCKETS - max_exact)).astype(jnp.int32)
    large = jnp.minimum(large, REL_BUCKETS - 1)
    return jnp.where(dist < max_exact, dist, large)


def stick_breaking_attention(q, k, v):
    bsz, L, nh, dh = q.shape
    scale = dh ** -0.5
    key_pos = jnp.arange(L)

    def block(i):
        q0 = i * Q_BLOCK
        q_pos = q0 + jnp.arange(Q_BLOCK)
        qb = lax.dynamic_slice_in_dim(q, q0, Q_BLOCK, axis=1)
        z = jnp.einsum('bqhd,bkhd->bhqk', qb, k).astype(jnp.float32) * scale
        strict = key_pos[None, :] < q_pos[:, None]
        log_1mb = jnp.where(strict, jax.nn.log_sigmoid(-z), 0.0)
        suffix = lax.cumsum(log_1mb, axis=3, reverse=True) - log_1mb
        att = jnp.where(strict, jnp.exp(jax.nn.log_sigmoid(z) + suffix), 0.0)
        return jnp.einsum('bhqk,bkhd->bqhd', att, v.astype(jnp.float32)).astype(q.dtype)

    out = lax.map(block, jnp.arange(L // Q_BLOCK))
    return jnp.moveaxis(out, 0, 1).reshape(bsz, L, nh * dh)


def dilated_attention(q, k, v, rel_bias):
    bsz, L, _, dh = q.shape
    hg = DIL_HEADS_PER_GROUP
    scale = dh ** -0.5
    groups = [(q[:, :, g * hg:(g + 1) * hg], k[:, :, g * hg:(g + 1) * hg], v[:, :, g * hg:(g + 1) * hg],
               rel_bias[:, g * hg:(g + 1) * hg], window, dil)
              for g, (window, dil) in enumerate(DIL_PATTERNS)]

    def block(i):
        q0 = i * Q_BLOCK
        q_pos = q0 + jnp.arange(Q_BLOCK)
        outs, lses = [], []
        for qg, kg, vg, bg, window, dil in groups:
            steps = jnp.arange(window // dil + 1)
            idx = q_pos[:, None] - dil * steps[None, :]
            valid = idx >= 0
            idx = jnp.maximum(idx, 0)
            qb = lax.dynamic_slice_in_dim(qg, q0, Q_BLOCK, axis=1)
            kb = jnp.take(kg, idx, axis=1)
            vb = jnp.take(vg, idx, axis=1)
            s = jnp.einsum('bqhd,bqkhd->bhqk', qb, kb).astype(jnp.float32) * scale
            bias = bg[t5_bucket(dil * steps)].astype(jnp.float32)
            s = jnp.where(valid[None, None], s + bias.T[None, :, None, :], NEG_INF)
            lse = jax.nn.logsumexp(s, axis=-1)
            p = jnp.exp(s - lse[..., None])
            outs.append(jnp.einsum('bhqk,bqkhd->bqhd', p, vb.astype(jnp.float32)))
            lses.append(lse)
        wts = jax.nn.softmax(jnp.stack(lses), axis=0)
        o = jnp.einsum('gbhq,gbqhd->bqhd', wts, jnp.stack(outs))
        return o.astype(q.dtype)

    out = lax.map(block, jnp.arange(L // Q_BLOCK))
    return jnp.moveaxis(out, 0, 1).reshape(bsz, L, hg * dh)


def _complex_linear_combine(e1, e2):
    a1r, a1i, b1r, b1i = e1
    a2r, a2i, b2r, b2i = e2
    return (a2r * a1r - a2i * a1i, a2r * a1i + a2i * a1r,
            a2r * b1r - a2i * b1i + b2r, a2r * b1i + a2i * b1r + b2i)


def s5_glu(u, lam_re, lam_im, log_dt, b_re, b_im, c_re, c_im, d_skip, w_glu):
    bsz, L, _ = u.shape
    f32 = jnp.float32
    uf = u.astype(f32).reshape(bsz, L, SSM_GROUPS, SSM_GROUP)
    lr, li = lam_re.astype(f32), lam_im.astype(f32)
    dt = jnp.exp(log_dt.astype(f32))[:, None]
    mag = jnp.exp(lr * dt)
    a_re, a_im = mag * jnp.cos(li * dt), mag * jnp.sin(li * dt)
    den = lr * lr + li * li
    f_re = ((a_re - 1.0) * lr + a_im * li) / den
    f_im = (a_im * lr - (a_re - 1.0) * li) / den
    br, bi = b_re.astype(f32), b_im.astype(f32)
    bb_re = f_re[..., None] * br - f_im[..., None] * bi
    bb_im = f_re[..., None] * bi + f_im[..., None] * br
    bu_re = jnp.einsum('blgc,gpc->blgp', uf, bb_re)
    bu_im = jnp.einsum('blgc,gpc->blgp', uf, bb_im)
    a_re_l = jnp.broadcast_to(a_re, (1, L) + a_re.shape)
    a_im_l = jnp.broadcast_to(a_im, (1, L) + a_im.shape)
    _, _, x_re, x_im = lax.associative_scan(_complex_linear_combine, (a_re_l, a_im_l, bu_re, bu_im), axis=1)
    y = (jnp.einsum('gcp,blgp->blgc', c_re.astype(f32), x_re)
         - jnp.einsum('gcp,blgp->blgc', c_im.astype(f32), x_im)
         + d_skip.astype(f32).reshape(SSM_GROUPS, SSM_GROUP) * uf)
    y = jax.nn.gelu(y.reshape(bsz, L, SSM_WIDTH)).astype(u.dtype)
    ga, gb = jnp.split(y @ w_glu, 2, axis=-1)
    return ga * jax.nn.sigmoid(gb)


def dsa_attention(q, k, v, q_idx, k_idx, w_idx, rel_bias):
    bsz, L, nh, dh = q.shape
    top_k = min(DSA_TOPK, L // 4)
    scale = dh ** -0.5
    key_pos = jnp.arange(L)

    def block(i):
        q0 = i * Q_BLOCK
        q_pos = q0 + jnp.arange(Q_BLOCK)
        qi = lax.dynamic_slice_in_dim(q_idx, q0, Q_BLOCK, axis=1)
        wi = lax.dynamic_slice_in_dim(w_idx, q0, Q_BLOCK, axis=1)
        dots = jnp.einsum('bqhd,bkd->bqhk', qi, k_idx).astype(jnp.float32)
        index_score = jnp.einsum('bqh,bqhk->bqk', wi.astype(jnp.float32), jax.nn.relu(dots))
        index_score = jnp.where(key_pos[None, None, :] <= q_pos[None, :, None], index_score, NEG_INF)
        _, sel = lax.top_k(index_score, top_k)
        dist = q_pos[None, :, None] - sel
        valid = dist >= 0
        kb = jax.vmap(lambda kk, ii: kk[ii])(k, sel)
        vb = jax.vmap(lambda vv, ii: vv[ii])(v, sel)
        qb = lax.dynamic_slice_in_dim(q, q0, Q_BLOCK, axis=1)
        s = jnp.einsum('bqhd,bqkhd->bhqk', qb, kb).astype(jnp.float32) * scale
        bias = rel_bias[t5_bucket(jnp.maximum(dist, 0))].astype(jnp.float32)
        s = jnp.where(valid[:, None], s + jnp.transpose(bias, (0, 3, 1, 2)), NEG_INF)
        p = jax.nn.softmax(s, axis=-1)
        return jnp.einsum('bhqk,bqkhd->bqhd', p, vb.astype(jnp.float32)).astype(q.dtype)

    out = lax.map(block, jnp.arange(L // Q_BLOCK))
    return jnp.moveaxis(out, 0, 1).reshape(bsz, L, nh * dh)


def hybrid_mixer(x, w_in, rel_bias, lam_re, lam_im, log_dt, b_re, b_im, c_re, c_im, d_skip, w_glu,
                 w_br_sb, w_br_dil, w_br_ssm, w_br_dsa, w_out):
    bsz, L, _ = x.shape
    h = x @ w_in
    sb_qkv, dil_qkv, ssm_u, dsa_qkv, idx_q, idx_k, idx_w, gate_logits = jnp.split(h, IN_OFFSETS, axis=-1)
    sb_qkv = sb_qkv.reshape(bsz, L, 3, SB_HEADS, HEAD_DIM)
    y_sb = stick_breaking_attention(sb_qkv[:, :, 0], sb_qkv[:, :, 1], sb_qkv[:, :, 2])
    dil_qkv = dil_qkv.reshape(bsz, L, 3, DIL_HEADS, HEAD_DIM)
    y_dil = dilated_attention(dil_qkv[:, :, 0], dil_qkv[:, :, 1], dil_qkv[:, :, 2], rel_bias[:, :DIL_HEADS])
    y_ssm = s5_glu(ssm_u, lam_re, lam_im, log_dt, b_re, b_im, c_re, c_im, d_skip, w_glu)
    dsa_qkv = dsa_qkv.reshape(bsz, L, 3, DSA_HEADS, HEAD_DIM)
    y_dsa = dsa_attention(dsa_qkv[:, :, 0], dsa_qkv[:, :, 1], dsa_qkv[:, :, 2],
                          idx_q.reshape(bsz, L, IDX_HEADS, IDX_DIM), idx_k, idx_w, rel_bias[:, DIL_HEADS:])
    gates = jax.nn.sigmoid(gate_logits.reshape(bsz, L, N_BRANCH, D_MODEL))
    merged = (gates[:, :, 0] * (y_sb @ w_br_sb) + gates[:, :, 1] * (y_dil @ w_br_dil)
              + gates[:, :, 2] * (y_ssm @ w_br_ssm) + gates[:, :, 3] * (y_dsa @ w_br_dsa))
    return merged @ w_out


def setup_inputs(seed: int = 0) -> dict:
    key = jax.random.key(seed)
    ks = jax.random.split(key, 24)
    f32 = jnp.float32

    def nrm(k, shape, scale):
        return jax.random.normal(k, shape, f32) * scale

    G, P, C = SSM_GROUPS, SSM_STATE, SSM_GROUP
    return {
        "x": nrm(ks[0], (BATCH, SEQ, D_MODEL), 1.0),
        "ln_g": 1.0 + nrm(ks[1], (DEPTH, 3, D_MODEL), 0.02),
        "ln_b": nrm(ks[2], (DEPTH, 3, D_MODEL), 0.02),
        "ffn1_w_up": nrm(ks[3], (DEPTH, D_MODEL, 2 * D_FF), D_MODEL ** -0.5),
        "ffn1_w_down": nrm(ks[4], (DEPTH, D_FF, D_MODEL), DN_BETA * D_FF ** -0.5),
        "w_in": nrm(ks[5], (DEPTH, D_MODEL, IN_COLS), D_MODEL ** -0.5),
        "rel_bias": nrm(ks[6], (REL_BUCKETS, REL_HEADS), 0.2),
        "ssm_lam_re": -0.5 + nrm(ks[7], (DEPTH, G, P), 0.01),
        "ssm_lam_im": math.pi * jnp.arange(P, dtype=f32) + nrm(ks[8], (DEPTH, G, P), 0.01),
        "ssm_log_dt": jax.random.uniform(ks[9], (DEPTH, G), f32, math.log(1e-3), math.log(1e-1)),
        "ssm_b_re": nrm(ks[10], (DEPTH, G, P, C), C ** -0.5),
        "ssm_b_im": nrm(ks[11], (DEPTH, G, P, C), C ** -0.5),
        "ssm_c_re": nrm(ks[12], (DEPTH, G, C, P), P ** -0.5),
        "ssm_c_im": nrm(ks[13], (DEPTH, G, C, P), P ** -0.5),
        "ssm_d": nrm(ks[14], (DEPTH, SSM_WIDTH), 1.0),
        "ssm_w_glu": nrm(ks[15], (DEPTH, SSM_WIDTH, 2 * SSM_WIDTH), SSM_WIDTH ** -0.5),
        "w_br_sb": nrm(ks[16], (DEPTH, SB_HEADS * HEAD_DIM, D_MODEL), (SB_HEADS * HEAD_DIM) ** -0.5),
        "w_br_dil": nrm(ks[17], (DEPTH, DIL_HEADS_PER_GROUP * HEAD_DIM, D_MODEL), (DIL_HEADS_PER_GROUP * HEAD_DIM) ** -0.5),
        "w_br_ssm": nrm(ks[18], (DEPTH, SSM_WIDTH, D_MODEL), SSM_WIDTH ** -0.5),
        "w_br_dsa": nrm(ks[19], (DEPTH, DSA_HEADS * HEAD_DIM, D_MODEL), (DSA_HEADS * HEAD_DIM) ** -0.5),
        "w_out": nrm(ks[20], (DEPTH, D_MODEL, D_MODEL), DN_BETA * D_MODEL ** -0.5),
        "ffn2_w_up": nrm(ks[21], (DEPTH, D_MODEL, 2 * D_FF), D_MODEL ** -0.5),
        "ffn2_w_down": nrm(ks[22], (DEPTH, D_FF, D_MODEL), DN_BETA * D_FF ** -0.5),
    }


def reference(x, ln_g, ln_b, ffn1_w_up, ffn1_w_down, w_in, rel_bias, ssm_lam_re, ssm_lam_im, ssm_log_dt,
              ssm_b_re, ssm_b_im, ssm_c_re, ssm_c_im, ssm_d, ssm_w_glu, w_br_sb, w_br_dil, w_br_ssm, w_br_dsa,
              w_out, ffn2_w_up, ffn2_w_down):
    for l in range(DEPTH):
        x = layer_norm(DN_ALPHA * x + MACARON * swiglu_ffn(x, ffn1_w_up[l], ffn1_w_down[l]), ln_g[l, 0], ln_b[l, 0])
        mix = hybrid_mixer(x, w_in[l], rel_bias, ssm_lam_re[l], ssm_lam_im[l], ssm_log_dt[l],
                           ssm_b_re[l], ssm_b_im[l], ssm_c_re[l], ssm_c_im[l], ssm_d[l], ssm_w_glu[l],
                           w_br_sb[l], w_br_dil[l], w_br_ssm[l], w_br_dsa[l], w_out[l])
        x = layer_norm(DN_ALPHA * x + mix, ln_g[l, 1], ln_b[l, 1])
        x = layer_norm(DN_ALPHA * x + MACARON * swiglu_ffn(x, ffn2_w_up[l], ffn2_w_down[l]), ln_g[l, 2], ln_b[l, 2])
    return x
```

```cpp
#include <hip/hip_runtime.h>
#include <cstdio>
#include <cstdint>
namespace pg8 {
#define PG8_LAS __attribute__((address_space(3)))
typedef unsigned short bf16_t;
typedef short bf16x8 __attribute__((ext_vector_type(8)));
typedef float f32x4 __attribute__((ext_vector_type(4)));
typedef unsigned u32x4 __attribute__((ext_vector_type(4)));
constexpr int BM = 256, BK = 64, HALF = 128, HTB = HALF * BK * 2  , STAGE_BYTES = 8 * HTB, NXCD = 8, WGM = 4;

__host__ __device__ __forceinline__ int lds_byte(int r, int c) { const int st = (r >> 4) * 2 + (c >> 5), rr = r & 15, cc = c & 31, ob = rr * 64 + cc * 2; return st * 1024 + (ob ^ (((ob >> 9) & 1) << 5)); }
__host__ __device__ __forceinline__ void stage_rc(int b, int& R, int& C) { const int st = b / 1024, sb = b % 1024, swz = sb ^ (((sb >> 9) & 1) << 5); R = (st >> 1) * 16 + swz / 64; C = (st & 1) * 32 + (swz % 64) / 2; }
__host__ __device__ __forceinline__ int perm32(int rho) { const int n = rho >> 4, i = rho & 15; return 8 * (i >> 2) + 4 * n + (i & 3); }

struct Unit { int pm, pn; };
struct Gemm { const bf16_t* A; const bf16_t* Bt; int M, N, K; };

struct StaticOrder {
    int nM, nN, nwg, G, c, wgm;
    __host__ __device__ void init(int M, int N, int G_, int c_, int wgm_ = WGM) { nM = M / BM; nN = N / BM; nwg = nM * nN; G = G_; c = c_; wgm = wgm_; }
    __host__ __device__ bool next(int i, Unit& u) const {
        const long L = (long)i * G + c; if (L >= nwg) return false;
        int wgid = (int)L; { const int q = nwg / NXCD, r = nwg % NXCD, xcd = wgid % NXCD, off = wgid / NXCD; wgid = (xcd < r ? xcd * (q + 1) : r * (q + 1) + (xcd - r) * q) + off; }
        const int nig = wgm * nN, gid = wgid / nig, fm = gid * wgm, gsz = (nM - fm) < wgm ? (nM - fm) : wgm;
        u.pm = fm + ((wgid % nig) % gsz); u.pn = (wgid % nig) / gsz; return true;
    }
    __device__ __forceinline__ void a_ready(const Unit&) const {}
    __device__ __forceinline__ void done(const Unit&) const {}
};

__device__ __forceinline__ unsigned cvt_pk_bf16(float lo, float hi) { unsigned r; asm volatile("v_cvt_pk_bf16_f32 %0, %1, %2" : "=v"(r) : "v"(lo), "v"(hi)); return r; }
typedef float f32x2 __attribute__((ext_vector_type(2)));
__device__ __forceinline__ float sigmoid_f(float a) { return __builtin_amdgcn_rcpf(1.0f + __builtin_amdgcn_exp2f(-1.4426950408889634f * a)); }
__device__ __forceinline__ float bf_lo(unsigned w) { return __uint_as_float(w << 16); }
__device__ __forceinline__ float bf_hi(unsigned w) { return __uint_as_float(w & 0xffff0000u); }
typedef float f32x2e __attribute__((ext_vector_type(2)));
template <int MODE> struct EpiPair {
    static constexpr bool PERM = true, AFTER_DRAIN = false;
    bf16_t* O; int ldo;
    __device__ __forceinline__ void operator()(f32x4 (&acc)[2][2][4][2], const Unit& u, int wr, int wc, int fr, int fq) const {
        const int row0 = u.pm * BM + wr * 64 + fr, col0 = u.pn * HALF + wc * 32 + 8 * fq;
#pragma unroll
        for (int ai = 0; ai < 2; ++ai)
#pragma unroll
            for (int m = 0; m < 4; ++m) { bf16_t* rowp = O + (size_t)(row0 + ai * HALF + m * 16) * ldo + col0;
                float r[8];
#pragma unroll
                for (int n = 0; n < 2; ++n) { const f32x4 av = acc[ai][0][m][n], bv = acc[ai][1][m][n];
#pragma unroll
                    for (int i = 0; i < 4; ++i) { const float a = av[i], b = bv[i];
                        r[n * 4 + i] = (MODE == 0) ? a * sigmoid_f(a) * b : a * sigmoid_f(b); } }
                u32x4 w; w.x = cvt_pk_bf16(r[0], r[1]); w.y = cvt_pk_bf16(r[2], r[3]); w.z = cvt_pk_bf16(r[4], r[5]); w.w = cvt_pk_bf16(r[6], r[7]);
                *(u32x4*)rowp = w;
                if (m & 1) __builtin_amdgcn_sched_barrier(0); }
    }
};
struct EpiH {
    static constexpr bool PERM = true, AFTER_DRAIN = false;
    bf16_t* O; int ldo; int gate_tile0; bf16_t* gt; bf16_t* vts; bf16_t* vtd; bf16_t* vta;
    __device__ __forceinline__ void store_vt(f32x4 (&acc)[2][2][4][2], const Unit& u, int wr, int wc, int fr, int fq) const {
        bf16_t* vb; int nh, h0, lay = 0;
        if (u.pn < 6) { vb = vts; nh = 8; h0 = (u.pn - 4) * 4; } else if (u.pn < 15) { vb = vtd; nh = 12; h0 = (u.pn - 12) * 4; lay = u.pn - 12; } else { vb = vta; nh = 8; h0 = (u.pn - 21) * 4; }
        const int r0 = u.pm * BM + wr * 64 + fr, bl = r0 >> 11, t0 = r0 & 2047;
        const int pos0 = lay == 0 ? t0 : (lay == 1 ? (t0 & 3) * 512 + (t0 >> 2) : (t0 & 15) * 128 + (t0 >> 4));
        const int step_m = lay == 0 ? 16 : (lay == 1 ? 4 : 1), step_ai = 8 * step_m;
        bf16_t* p0 = vb + ((size_t)(bl * nh + h0 + (wc >> 1)) * 64 + 32 * (wc & 1) + 8 * fq) * 2048 + pos0;
#pragma unroll
        for (int ai = 0; ai < 2; ++ai)
#pragma unroll
            for (int m = 0; m < 4; ++m)
#pragma unroll
                for (int bj = 0; bj < 2; ++bj) { bf16_t* p = p0 + (size_t)bj * (2 * 64 * 2048) + ai * step_ai + m * step_m;
#pragma unroll
                    for (int n = 0; n < 2; ++n)
#pragma unroll
                        for (int i = 0; i < 4; i += 2) { const unsigned w = cvt_pk_bf16(acc[ai][bj][m][n][i], acc[ai][bj][m][n][i + 1]);
                            p[(size_t)(4 * n + i) * 2048] = (bf16_t)(w & 0xffffu); p[(size_t)(4 * n + i + 1) * 2048] = (bf16_t)(w >> 16); } }
    }
    __device__ __forceinline__ void operator()(f32x4 (&acc)[2][2][4][2], const Unit& u, int wr, int wc, int fr_in, int fq) const {
        int fr = fr_in; asm volatile("" : "+v"(fr));
        if (u.pn == 4 || u.pn == 5 || (u.pn >= 12 && u.pn <= 14) || u.pn == 21 || u.pn == 22) { store_vt(acc, u, wr, wc, fr, fq); return; }
        const int row0 = u.pm * BM + wr * 64 + fr, col0 = u.pn * BM + wc * 32 + 8 * fq; const bool sg = u.pn >= gate_tile0;
#pragma unroll
        for (int ai = 0; ai < 2; ++ai)
#pragma unroll
            for (int m = 0; m < 4; ++m) { bf16_t* rowp = O + (size_t)(row0 + ai * HALF + m * 16) * ldo + col0;
                if (sg) { const int gp = u.pn - gate_tile0;
                    rowp = gt + ((size_t)(u.pm * 4 + (gp >> 3)) * 8 + (gp & 7)) * 65536 + (size_t)(wr * 64 + fr + ai * HALF + m * 16) * 256 + wc * 32 + 8 * fq; }
#pragma unroll
                for (int bj = 0; bj < 2; ++bj) { f32x4 v0 = acc[ai][bj][m][0], v1 = acc[ai][bj][m][1];
                    if (sg) {
#pragma unroll
                        for (int i = 0; i < 4; ++i) { v0[i] = sigmoid_f(v0[i]); v1[i] = sigmoid_f(v1[i]); } }
                    u32x4 w; w.x = cvt_pk_bf16(v0[0], v0[1]); w.y = cvt_pk_bf16(v0[2], v0[3]); w.z = cvt_pk_bf16(v1[0], v1[1]); w.w = cvt_pk_bf16(v1[2], v1[3]);
                    *(u32x4*)(rowp + bj * HALF) = w; }
                if (m & 1) __builtin_amdgcn_sched_barrier(0); }
    }
};
struct EpiResid {
    static constexpr bool PERM = false, AFTER_DRAIN = false;
    const float* base; float* out; const f32x2e* stat; const float* g; const float* b; int ldc, nrm; float alpha, sc;
    __device__ __forceinline__ void operator()(f32x4 (&acc)[2][2][4][2], const Unit& u, int wr, int wc, int fr, int fq) const {
        const int col0 = u.pn * BM + wc * 32 + 4 * fq, row0 = u.pm * BM + wr * 64 + fr;
        f32x4 gg[2][2], bb[2][2];
#pragma unroll
        for (int bj = 0; bj < 2; ++bj)
#pragma unroll
            for (int n = 0; n < 2; ++n) { gg[bj][n] = (f32x4){1.f, 1.f, 1.f, 1.f}; bb[bj][n] = (f32x4){0.f, 0.f, 0.f, 0.f};
                if (nrm) { gg[bj][n] = *(const f32x4*)(g + col0 + bj * HALF + n * 16); bb[bj][n] = *(const f32x4*)(b + col0 + bj * HALF + n * 16); } }
        f32x2e stq[8];
        f32x4 yq[8][2][2];
#define PG8_RESID_REQ(K) { const int rn = row0 + ((K) >> 2) * HALF + ((K) & 3) * 16; stq[K] = nrm ? stat[rn] : (f32x2e){0.f, 1.f}; \
            _Pragma("unroll") for (int bj = 0; bj < 2; ++bj) _Pragma("unroll") for (int n = 0; n < 2; ++n) yq[K][bj][n] = *(const f32x4*)(base + (size_t)rn * ldc + col0 + bj * HALF + n * 16); }
        PG8_RESID_REQ(0) PG8_RESID_REQ(1)
        __builtin_amdgcn_sched_barrier(0);
#pragma unroll
        for (int k = 0; k < 8; ++k) { const int ai = k >> 2, m = k & 3; const int row = row0 + ai * HALF + m * 16; const size_t off = (size_t)row * ldc + col0;
            const f32x2e st = stq[k];
#pragma unroll
            for (int bj = 0; bj < 2; ++bj)
#pragma unroll
                for (int n = 0; n < 2; ++n) { const size_t o2 = off + bj * HALF + n * 16;
                    const f32x4 xp = (yq[k][bj][n] - st.x) * st.y * gg[bj][n] + bb[bj][n];
                    const f32x4 y = xp * alpha + acc[ai][bj][m][n] * sc;
                    *(f32x4*)(out + o2) = y; }
            __builtin_amdgcn_sched_barrier(0);
            if (k < 3) { PG8_RESID_REQ(2 * k + 2) PG8_RESID_REQ(2 * k + 3) }
            __builtin_amdgcn_sched_barrier(0); }
#undef PG8_RESID_REQ
    }
};
struct EpiGateAcc {
    static constexpr bool PERM = true, AFTER_DRAIN = false;
    const bf16_t* G; int branch; bf16_t* O; int ldo; int first;
    __device__ __forceinline__ void operator()(f32x4 (&acc)[2][2][4][2], const Unit& u, int wr, int wc, int fr, int fq) const {
        const int row0 = u.pm * BM + wr * 64 + fr, col0 = u.pn * BM + wc * 32 + 8 * fq;
#pragma unroll
        for (int ai = 0; ai < 2; ++ai) {
            u32x4 gw[4][2], pw[4][2];
#pragma unroll
            for (int m = 0; m < 4; ++m)
#pragma unroll
                for (int bj = 0; bj < 2; ++bj) { const int row = row0 + ai * HALF + m * 16;
                    gw[m][bj] = *(const u32x4*)(G + ((size_t)(u.pm * 4 + branch) * 8 + u.pn) * 65536 + (size_t)(row - u.pm * BM) * 256 + wc * 32 + 8 * fq + bj * HALF);
                    pw[m][bj] = (u32x4){0u, 0u, 0u, 0u}; if (!first) pw[m][bj] = *(const u32x4*)(O + (size_t)row * ldo + col0 + bj * HALF); }
#pragma unroll
            for (int m = 0; m < 4; ++m)
#pragma unroll
                for (int bj = 0; bj < 2; ++bj) { const int row = row0 + ai * HALF + m * 16; bf16_t* op = O + (size_t)row * ldo + col0 + bj * HALF;
                    const f32x4 v0 = acc[ai][bj][m][0], v1 = acc[ai][bj][m][1]; const u32x4 g = gw[m][bj], p = pw[m][bj];
                    u32x4 w;
                    w.x = cvt_pk_bf16(bf_lo(p.x) + bf_lo(g.x) * v0[0], bf_hi(p.x) + bf_hi(g.x) * v0[1]);
                    w.y = cvt_pk_bf16(bf_lo(p.y) + bf_lo(g.y) * v0[2], bf_hi(p.y) + bf_hi(g.y) * v0[3]);
                    w.z = cvt_pk_bf16(bf_lo(p.z) + bf_lo(g.z) * v1[0], bf_hi(p.z) + bf_hi(g.z) * v1[1]);
                    w.w = cvt_pk_bf16(bf_lo(p.w) + bf_lo(g.w) * v1[2], bf_hi(p.w) + bf_hi(g.w) * v1[3]);
                    *(u32x4*)op = w; }
        }
    }
};
template <class Epi, class Sched, bool ALIGN_EPI = false, bool SP2 = false>
__device__ __forceinline__ void gemm_phase(PG8_LAS unsigned char* lds, const Gemm g, const Sched& S, const Epi& E, int tid_in) {
    int tid_ = tid_in; asm volatile("" : "+v"(tid_));
    const int tid = tid_, wid = __builtin_amdgcn_readfirstlane(tid >> 6), lane = tid & 63, wr = wid >> 2, wc = wid & 3, fr = lane & 15, fq = lane >> 4;
    const int K = g.K, nt = K / BK;
    unsigned voffA[2], voffB[2];
#pragma unroll
    for (int i = 0; i < 2; ++i) { int R, C; stage_rc(tid * 16 + i * 8192, R, C); const int Rb = Epi::PERM ? ((R & ~31) + perm32(R & 31)) : R;
        voffA[i] = (unsigned)(R * K + C) * 2u; voffB[i] = (unsigned)(Rb * K + C) * 2u; }
    const size_t kstep = (size_t)(BK * 2);
    const size_t hstep = (size_t)HALF * K * 2;
    const size_t tstep = 2 * hstep;
    const unsigned ldsw = (unsigned)wid * 1024u;
    const int aoff = lds_byte(wr * 64 + fr, fq * 8), boff = lds_byte(wc * 32 + fr, fq * 8);
#define PG8_SA(b, h) (((b) * 2 + (h)) * HTB)
#define PG8_SB(b, h) ((4 + (b) * 2 + (h)) * HTB)
#define PG8_STAGE(bufoff, gbase, voff) do { _Pragma("unroll") for (int _i = 0; _i < 2; ++_i) \
        __builtin_amdgcn_global_load_lds((const unsigned*)((const char*)(gbase) + (voff)[_i]), (PG8_LAS unsigned*)(lds + (bufoff) + ldsw + _i * 8192), 16, 0, 0); } while (0)
#define PG8_LDA(dst, b, h) do { _Pragma("unroll") for (int m = 0; m < 4; ++m) _Pragma("unroll") for (int k = 0; k < 2; ++k) dst[m][k] = *(const PG8_LAS bf16x8*)(lds + PG8_SA(b, h) + aoff + m * 2048 + k * 1024); } while (0)
#define PG8_LDB(dst, b, h) do { _Pragma("unroll") for (int n = 0; n < 2; ++n) _Pragma("unroll") for (int k = 0; k < 2; ++k) dst[n][k] = *(const PG8_LAS bf16x8*)(lds + PG8_SB(b, h) + boff + n * 2048 + k * 1024); } while (0)
#define PG8_MMA(ai, bj, At, Bt) do { __builtin_amdgcn_s_setprio(1); _Pragma("unroll") for (int m = 0; m < 4; ++m) _Pragma("unroll") for (int n = 0; n < 2; ++n) _Pragma("unroll") for (int k = 0; k < 2; ++k) \
        acc[ai][bj][m][n] = __builtin_amdgcn_mfma_f32_16x16x32_bf16(Bt[n][k], At[m][k], acc[ai][bj][m][n], 0, 0, 0); __builtin_amdgcn_s_setprio(0); } while (0)
#define PG8_WAIT_V(n) asm volatile("s_waitcnt vmcnt(" #n ")" ::: "memory")
#define PG8_WAIT_L(n) asm volatile("s_waitcnt lgkmcnt(" #n ")" ::: "memory")
#define PG8_BAR __builtin_amdgcn_s_barrier()
#define PG8_SCHED __builtin_amdgcn_sched_barrier(0)
    Unit cur, nxt; int ui = 0;
    if (!S.next(0, cur)) return;
    f32x4 acc[2][2][4][2];
#pragma unroll
    for (int a = 0; a < 2; ++a)
#pragma unroll
        for (int b = 0; b < 2; ++b)
#pragma unroll
            for (int m = 0; m < 4; ++m)
#pragma unroll
                for (int n = 0; n < 2; ++n) acc[a][b][m][n] = (f32x4){0.f, 0.f, 0.f, 0.f};
    bf16x8 At[4][2], B0[2][2], B1[2][2];
    const char* cA = (const char*)g.A + (size_t)cur.pm * tstep; const char* cB = (const char*)g.Bt + (size_t)cur.pn * tstep;
    S.a_ready(cur);
    if constexpr (SP2) {
        PG8_STAGE(PG8_SB(0, 0), cB, voffB); PG8_STAGE(PG8_SB(0, 1), cB + hstep, voffB); PG8_STAGE(PG8_SA(0, 0), cA, voffA); PG8_STAGE(PG8_SA(0, 1), cA + hstep, voffA);
        if (wr == 1) PG8_BAR;
        PG8_WAIT_V(2); PG8_BAR;
        PG8_STAGE(PG8_SB(1, 0), cB + kstep, voffB); PG8_STAGE(PG8_SA(1, 0), cA + kstep, voffA); PG8_STAGE(PG8_SB(1, 1), cB + hstep + kstep, voffB);
        PG8_WAIT_V(6); PG8_BAR;
    } else {
        PG8_STAGE(PG8_SB(0, 0), cB, voffB); PG8_STAGE(PG8_SA(0, 0), cA, voffA); PG8_STAGE(PG8_SB(0, 1), cB + hstep, voffB); PG8_STAGE(PG8_SA(0, 1), cA + hstep, voffA);
        if (wr == 1) PG8_BAR;
        PG8_WAIT_V(4); PG8_BAR;
        PG8_STAGE(PG8_SB(1, 0), cB + kstep, voffB); PG8_STAGE(PG8_SA(1, 0), cA + kstep, voffA); PG8_STAGE(PG8_SB(1, 1), cB + hstep + kstep, voffB);
        PG8_WAIT_V(6); PG8_BAR;
    }
    for (;;) {
        const bool has_next = S.next(ui + 1, nxt);
        const char* nA = has_next ? (const char*)g.A + (size_t)nxt.pm * tstep : cA; const char* nB = has_next ? (const char*)g.Bt + (size_t)nxt.pn * tstep : cB;
        for (int t = 0; t < nt; t += 2) {
            const bool last = (t == nt - 2);
            const char* a1 = cA + (size_t)(t + 1) * kstep;
            const char* a2 = last ? nA : cA + (size_t)(t + 2) * kstep; const char* b2 = last ? nB : cB + (size_t)(t + 2) * kstep;
            const char* a3 = a2 + kstep; const char* b3 = b2 + kstep;
            if (last && has_next) S.a_ready(nxt);
            if constexpr (SP2) {
            PG8_LDB(B0, 0, 0); PG8_LDB(B1, 0, 1); PG8_SCHED; PG8_LDA(At, 0, 0); PG8_STAGE(PG8_SA(1, 1), a1 + hstep, voffA);
            PG8_WAIT_V(8); PG8_WAIT_L(0); PG8_BAR; PG8_MMA(0, 0, At, B0); PG8_MMA(0, 1, At, B1); PG8_BAR; PG8_SCHED;
            PG8_LDA(At, 0, 1); PG8_STAGE(PG8_SB(0, 0), b2, voffB); PG8_STAGE(PG8_SB(0, 1), b2 + hstep, voffB); PG8_STAGE(PG8_SA(0, 0), a2, voffA);
            PG8_WAIT_V(8); PG8_WAIT_L(0); PG8_BAR; PG8_MMA(1, 0, At, B0); PG8_MMA(1, 1, At, B1); PG8_BAR; PG8_SCHED;
            PG8_LDB(B0, 1, 0); PG8_LDB(B1, 1, 1); PG8_SCHED; PG8_LDA(At, 1, 0); PG8_STAGE(PG8_SA(0, 1), a2 + hstep, voffA);
            PG8_WAIT_V(8); PG8_WAIT_L(0); PG8_BAR; PG8_MMA(0, 0, At, B0); PG8_MMA(0, 1, At, B1); PG8_BAR; PG8_SCHED;
            PG8_LDA(At, 1, 1); PG8_STAGE(PG8_SB(1, 0), b3, voffB); PG8_STAGE(PG8_SB(1, 1), b3 + hstep, voffB); PG8_STAGE(PG8_SA(1, 0), a3, voffA);
            PG8_WAIT_V(8); PG8_WAIT_L(0); PG8_BAR; PG8_MMA(1, 0, At, B0); PG8_MMA(1, 1, At, B1); PG8_BAR; PG8_SCHED;
            } else {
            PG8_LDB(B0, 0, 0); PG8_SCHED; PG8_LDA(At, 0, 0); PG8_STAGE(PG8_SA(1, 1), a1 + hstep, voffA);
            PG8_WAIT_L(8); PG8_BAR; PG8_WAIT_L(0); PG8_MMA(0, 0, At, B0); PG8_BAR; PG8_SCHED;
            PG8_LDB(B1, 0, 1); PG8_STAGE(PG8_SB(0, 0), b2, voffB);
            PG8_BAR; PG8_WAIT_L(0); PG8_MMA(0, 1, At, B1); PG8_BAR;
            PG8_LDA(At, 0, 1); PG8_STAGE(PG8_SA(0, 0), a2, voffA);
            PG8_BAR; PG8_WAIT_L(0); PG8_MMA(1, 0, At, B0); PG8_BAR; PG8_SCHED;
            PG8_STAGE(PG8_SB(0, 1), b2 + hstep, voffB);
            PG8_WAIT_V(6); PG8_BAR; PG8_MMA(1, 1, At, B1); PG8_BAR;
            PG8_LDB(B0, 1, 0); PG8_SCHED; PG8_LDA(At, 1, 0); PG8_STAGE(PG8_SA(0, 1), a2 + hstep, voffA);
            PG8_WAIT_L(8); PG8_BAR; PG8_WAIT_L(0); PG8_MMA(0, 0, At, B0); PG8_BAR; PG8_SCHED;
            PG8_LDB(B1, 1, 1); PG8_STAGE(PG8_SB(1, 0), b3, voffB);
            PG8_BAR; PG8_WAIT_L(0); PG8_MMA(0, 1, At, B1); PG8_BAR;
            PG8_LDA(At, 1, 1); PG8_STAGE(PG8_SA(1, 0), a3, voffA);
            PG8_BAR; PG8_WAIT_L(0); PG8_MMA(1, 0, At, B0); PG8_BAR; PG8_SCHED;
            PG8_STAGE(PG8_SB(1, 1), b3 + hstep, voffB);
            PG8_WAIT_V(6); PG8_BAR; PG8_MMA(1, 1, At, B1); PG8_BAR;
            }
        }
        if constexpr (ALIGN_EPI) { if (wr == 0) PG8_BAR; }
        if constexpr (!Epi::AFTER_DRAIN) { E(acc, cur, wr, wc, fr, fq); S.done(cur); }
        if (!has_next) break;
#pragma unroll
        for (int a = 0; a < 2; ++a)
#pragma unroll
            for (int b = 0; b < 2; ++b)
#pragma unroll
                for (int m = 0; m < 4; ++m)
#pragma unroll
                    for (int n = 0; n < 2; ++n) acc[a][b][m][n] = (f32x4){0.f, 0.f, 0.f, 0.f};
        cur = nxt; cA = nA; cB = nB; ++ui;
        if constexpr (ALIGN_EPI) { if (wr == 1) PG8_BAR; }
    }
    PG8_WAIT_V(0);
    if constexpr (!ALIGN_EPI) { if (wr == 0) PG8_BAR; }
    PG8_BAR;
    if constexpr (Epi::AFTER_DRAIN) { E.fused(acc, cur, wr, wc, fr, fq, lds, wid, lane); S.done(cur); }
#undef PG8_SA
#undef PG8_SB
#undef PG8_STAGE
#undef PG8_LDA
#undef PG8_LDB
#undef PG8_MMA
#undef PG8_WAIT_V
#undef PG8_WAIT_L
#undef PG8_BAR
#undef PG8_SCHED
}
}

constexpr int NWAVES = 8;
#ifndef WGM_UP
#define WGM_UP 8
#endif
#ifndef MK_ONE_LAUNCH
#define MK_ONE_LAUNCH 1
#endif
constexpr int BATCH = 16, SEQ = 2048, D = 2048, M = BATCH * SEQ, DFF = 5632, NUP = 2 * DFF, DEPTH = 2;
constexpr int INC = 14664, NH = 14848, HP = 6656, GATE_T0 = 26;
constexpr int NCH = 2, MC = M / NCH, BC = BATCH / NCH;
constexpr int C_SBQ = 0, C_SBK = 512, C_SBV = 1024, C_DQ = 1536, C_DK = 2304, C_DV = 3072, C_U = 3840, C_AQ = 4352, C_AK = 4864, C_AV = 5376, C_IQ = 5888, C_IK = 6400, C_IW = 6464, C_GATE = 6656;
constexpr float LOG2E = 1.4426950408889634f, QSC = 0.125f * 1.4426950408889634f, DN_ALPHA = 1.4142135623730951f, LN_EPS = 1e-5f;
constexpr size_t MiB = 1u << 20;
constexpr size_t WS_CTL = 0, CTL_ZERO_BYTES = 1 * MiB;
constexpr size_t WS_WT = 1 * MiB;
constexpr size_t W_1U = 0, W_1D = W_1U + (size_t)NUP * D, W_IN = W_1D + (size_t)D * DFF, W_GLU = W_IN + (size_t)NH * D, W_SB = W_GLU + 1024 * 512, W_DIL = W_SB + 2048 * 512,
                 W_SSM = W_DIL + 2048 * 256, W_DSA = W_SSM + 2048 * 512, W_OUT = W_DSA + 2048 * 512, W_2U = W_OUT + (size_t)D * D, W_2D = W_2U + (size_t)NUP * D, W_END = W_2D + (size_t)D * DFF;
static_assert(W_END * 2 <= 207 * MiB, "weights region");
constexpr size_t WS_XB = 208 * MiB;
constexpr size_t WS_MG = 336 * MiB;
constexpr size_t WS_H = 464 * MiB, WS_GT = WS_H + 208 * MiB;
constexpr size_t WS_YSB = 928 * MiB, WS_YDIL = 944 * MiB, WS_YSSM = 952 * MiB, WS_YDSA = 968 * MiB, WS_YG = 984 * MiB, WS_MASK = 1000 * MiB, WS_VTS = 1004 * MiB, WS_VTD = 1020 * MiB, WS_VTA = 1044 * MiB, WS_SSMT = 1060 * MiB, WS_END = 1070 * MiB;
static_assert((size_t)MC * HP * 2 <= 208 * MiB && (size_t)(MC / 256) * 32 * 65536 * 2 <= 256 * MiB && (size_t)M * DFF * 2 <= 464 * MiB, "h region");
constexpr size_t WS_STAT = WS_CTL + 512 * 1024;
constexpr int CW_BAR = 4096;
constexpr int RING_OFF = 0, RING_BYTES = 131072, LDSCTL_OFF = RING_BYTES, MISC_OFF = LDSCTL_OFF + 320, LDS_BYTES = 147456;

#define GAS __attribute__((address_space(1)))
#define LAS __attribute__((address_space(3)))
typedef unsigned short bf16;
typedef unsigned v4u __attribute__((ext_vector_type(4)));
typedef float f32x4 __attribute__((ext_vector_type(4)));
typedef GAS unsigned gu32;
typedef float f32x2v_ __attribute__((ext_vector_type(2)));
#define RLX_AGENT __ATOMIC_RELAXED, __HIP_MEMORY_SCOPE_AGENT
#define LDS_WAIT() asm volatile("s_waitcnt lgkmcnt(0)" ::: "memory")
#define VM_WAIT() asm volatile("s_waitcnt vmcnt(0)" ::: "memory")
__device__ __forceinline__ unsigned f2bf(float f) { unsigned u = __builtin_bit_cast(unsigned, f); return (u + 0x7fffu + ((u >> 16) & 1u)) >> 16; }
__device__ __forceinline__ unsigned pk2(float lo, float hi) { return f2bf(lo) | (f2bf(hi) << 16); }
__device__ __forceinline__ float bflo(unsigned w) { return __uint_as_float(w << 16); }
__device__ __forceinline__ float bfhi(unsigned w) { return __uint_as_float(w & 0xffff0000u); }
__device__ __forceinline__ void ld8(const bf16* p, float* f) { const v4u w = *(const GAS v4u*)p; f[0] = bflo(w.x); f[1] = bfhi(w.x); f[2] = bflo(w.y); f[3] = bfhi(w.y); f[4] = bflo(w.z); f[5] = bfhi(w.z); f[6] = bflo(w.w); f[7] = bfhi(w.w); }
__device__ __forceinline__ void st8(bf16* p, const float* f) { v4u w; w.x = pk2(f[0], f[1]); w.y = pk2(f[2], f[3]); w.z = pk2(f[4], f[5]); w.w = pk2(f[6], f[7]); *(GAS v4u*)p = w; }
__device__ __forceinline__ float ex2(float x) { return __builtin_amdgcn_exp2f(x); }
__device__ __forceinline__ float lg2(float x) { return __builtin_amdgcn_logf(x); }
__device__ __forceinline__ float wave_sum(float v) {
#pragma unroll
    for (int o = 1; o < 64; o <<= 1) v += __shfl_xor(v, o);
    return v;
}
__device__ __forceinline__ int t5_bucket(int d) {
    if (d < 16) return d;
    return 15 + (d >= 16) + (d >= 19) + (d >= 21) + (d >= 24) + (d >= 27) + (d >= 31) + (d >= 35) + (d >= 40) + (d >= 46) + (d >= 52) + (d >= 59) + (d >= 67) + (d >= 77) + (d >= 87) + (d >= 99) + (d >= 113);
}

#define XB_TMO      128
#define XB_XCNT(j)  (256  + 64 * (j))
#define XB_XSUB(j)  (1280 + 64 * (j))
#define XB_XGEN(j)  (2304 + 64 * (j))
#define XB_TOP      3328
#define XB_TOPGEN   3392
#define XCD_BAR_WORDS 3456
#define XB_SPIN_CAP (1u << 18)

__device__ __forceinline__ unsigned xb_ld(unsigned* p)              { return __hip_atomic_load(p, __ATOMIC_RELAXED, __HIP_MEMORY_SCOPE_AGENT); }
__device__ __forceinline__ unsigned xb_add(unsigned* p, unsigned v) { return __hip_atomic_fetch_add(p, v, __ATOMIC_RELAXED, __HIP_MEMORY_SCOPE_AGENT); }
__device__ __forceinline__ unsigned xb_xcc_id() { return (unsigned)__builtin_amdgcn_s_getreg((3 << 11) | 20) & 0xFu; }
#define XB_SPIN(cond, bar) do { unsigned _sp = 0; while (cond) { __builtin_amdgcn_s_sleep(1); \
    if ((++_sp & 255u) == 0u) { if (xb_ld(&(bar)[XB_TMO])) break; if (_sp > XB_SPIN_CAP) { atomicAdd(&(bar)[XB_TMO], 1u); break; } } } } while (0)

struct XcdBarrier {
    unsigned* bar; unsigned x;
    volatile LAS unsigned* st;
};

__device__ __forceinline__ XcdBarrier xcd_barrier_post(unsigned* bar, volatile LAS unsigned* st) {
    XcdBarrier b; b.bar = bar; b.x = xb_xcc_id(); b.st = st;
    if (threadIdx.x == 0) (void)xb_add(&bar[XB_XCNT(b.x)], 1u);
    return b;
}
__device__ __forceinline__ void xcd_barrier_complete(unsigned* bar, unsigned x, unsigned& nloc, unsigned& nx) {
    const unsigned G = gridDim.x * gridDim.y * gridDim.z;
    unsigned sum, cnt, mine, sp = 0u;
    for (;;) {
        sum = 0u; cnt = 0u; mine = 0u;
#pragma unroll
        for (unsigned j = 0; j < 16; ++j) { const unsigned c = xb_ld(&bar[XB_XCNT(j)]); sum += c; cnt += (c > 0u) ? 1u : 0u; mine = (j == x) ? c : mine; }
        if (sum == G) break;
        __builtin_amdgcn_s_sleep(1);
        if ((++sp & 255u) == 0u) { if (xb_ld(&bar[XB_TMO])) break; if (sp > XB_SPIN_CAP) { atomicAdd(&bar[XB_TMO], 1u); break; } }
    }
    nloc = mine > 0u ? mine : 1u; nx = cnt > 0u ? cnt : 1u;
}

__device__ __forceinline__ void xcd_barrier(const XcdBarrier& b) {
    asm volatile("s_waitcnt vmcnt(0)" ::: "memory");
    __syncthreads();
    if (threadIdx.x == 0) {
        unsigned* bar = b.bar;
        __builtin_amdgcn_s_waitcnt(0);
        unsigned nloc = b.st[0], nx = b.st[1];
        if (nloc == 0u) { xcd_barrier_complete(bar, b.x, nloc, nx); b.st[0] = nloc; b.st[1] = nx; }
        const unsigned old = xb_add(&bar[XB_XSUB(b.x)], 1u);
        const unsigned gen = old / nloc;
        if (old + 1u == (gen + 1u) * nloc) {
            __builtin_amdgcn_fence(__ATOMIC_RELEASE, "agent");
            asm volatile("s_waitcnt vmcnt(0)" ::: "memory");
            const unsigned og = xb_add(&bar[XB_TOP], 1u);
            const unsigned tg = og / nx;
            if (og + 1u == (tg + 1u) * nx) xb_add(&bar[XB_TOPGEN], 1u);
            else XB_SPIN(xb_ld(&bar[XB_TOPGEN]) == tg, bar);
            __builtin_amdgcn_fence(__ATOMIC_ACQUIRE, "agent");
            xb_add(&bar[XB_XGEN(b.x)], 1u);
            asm volatile("s_waitcnt vmcnt(0)" ::: "memory");
        } else {
            XB_SPIN(xb_ld(&bar[XB_XGEN(b.x)]) == gen, bar);
            __builtin_amdgcn_fence(__ATOMIC_ACQUIRE, "agent");
            asm volatile("s_waitcnt vmcnt(0)" ::: "memory");
        }
    }
    __syncthreads();
}


struct Frame {
    LAS unsigned char* lds;
    int tid, lane, wave, G;
};

struct MapId { __device__ __forceinline__ void operator()(int np, int& src, float& sc) const { src = np; sc = 1.f; } };
struct MapPair { int half; __device__ __forceinline__ void operator()(int np, int& src, float& sc) const { const int pn = np >> 8, bj = (np >> 7) & 1, c = np & 127; src = bj * half + 128 * pn + c; sc = 1.f; } };
struct MapIn { __device__ __forceinline__ void operator()(int np, int& src, float& sc) const {
    if (np < 6472) { src = np; sc = (np < 512 || (np >= 1536 && np < 2304) || (np >= 4352 && np < 4864)) ? QSC : 1.f; }
    else if (np < C_GATE) { src = -1; sc = 0.f; }
    else { src = np - (C_GATE - 6472); sc = 1.f; } } };
template <class Map>
__device__ __forceinline__ void tr_item(const float* W, int K, int N, int nblk, bf16* WT, LAS float* scr, int item, int lane, const Map& map) {
    const int kb = item / nblk, nb = item % nblk, k0 = 64 * kb, n0 = 32 * nb;
    int src; float sc; map(n0 + 4 * (lane & 7), src, sc);
    const GAS float* col = (const GAS float*)W + (src < 0 ? 0 : src);
#pragma unroll
    for (int i = 0; i < 8; ++i) { const int kk = 8 * i + (lane >> 3); f32x4 v = *(const GAS f32x4*)(col + (size_t)(k0 + kk) * N); if (src < 0) v = (f32x4){0.f, 0.f, 0.f, 0.f}; v = v * sc;
        LAS float* d = scr + kk * 33 + 4 * (lane & 7); d[0] = v.x; d[1] = v.y; d[2] = v.z; d[3] = v.w; }
    LDS_WAIT(); asm volatile("" ::: "memory");
    const int c = lane & 7;
#pragma unroll
    for (int j = 0; j < 4; ++j) { const int n = (lane >> 3) + 8 * j; const LAS float* s = scr + (8 * c) * 33 + n;
        v4u o; o.x = pk2(s[0 * 33], s[1 * 33]); o.y = pk2(s[2 * 33], s[3 * 33]); o.z = pk2(s[4 * 33], s[5 * 33]); o.w = pk2(s[6 * 33], s[7 * 33]);
        *(GAS v4u*)(WT + (size_t)(n0 + n) * K + k0 + 8 * c) = o; }
    LDS_WAIT(); asm volatile("" ::: "memory");
}
struct WPtrs { const float *up1, *dn1, *win, *glu, *sb, *dil, *ssm, *dsa, *wout, *up2, *dn2; };
__device__ __forceinline__ void weights_phase(const Frame& F, const WPtrs& P, bf16* WT) {
    LAS float* scr = (LAS float*)(F.lds + RING_OFF + F.wave * 16384);
    int gw_ = blockIdx.x * NWAVES + F.wave; asm volatile("" : "+s"(gw_));
    const int gw = gw_, NGW = F.G * NWAVES;
    constexpr int I_UP = (D / 64) * (NUP / 32), I_IN = (D / 64) * (NH / 32), I_DN = (DFF / 64) * (D / 32), I_GLU = (512 / 64) * (1024 / 32), I_B5 = (512 / 64) * (D / 32), I_B2 = (256 / 64) * (D / 32), I_OUT = (D / 64) * (D / 32);
    constexpr int NITEMS = 2 * I_UP + I_IN + 2 * I_DN + I_GLU + 3 * I_B5 + I_B2 + I_OUT;
    for (int it = gw; it < NITEMS; it += NGW) {
        int r = it;
        if (r < I_UP) { tr_item(P.up1, D, NUP, NUP / 32, WT + W_1U, scr, r, F.lane, MapPair{DFF}); continue; } r -= I_UP;
        if (r < I_UP) { tr_item(P.up2, D, NUP, NUP / 32, WT + W_2U, scr, r, F.lane, MapPair{DFF}); continue; } r -= I_UP;
        if (r < I_IN) { tr_item(P.win, D, INC, NH / 32, WT + W_IN, scr, r, F.lane, MapIn{}); continue; } r -= I_IN;
        if (r < I_DN) { tr_item(P.dn1, DFF, D, D / 32, WT + W_1D, scr, r, F.lane, MapId{}); continue; } r -= I_DN;
        if (r < I_DN) { tr_item(P.dn2, DFF, D, D / 32, WT + W_2D, scr, r, F.lane, MapId{}); continue; } r -= I_DN;
        if (r < I_OUT) { tr_item(P.wout, D, D, D / 32, WT + W_OUT, scr, r, F.lane, MapId{}); continue; } r -= I_OUT;
        if (r < I_B5) { tr_item(P.sb, 512, D, D / 32, WT + W_SB, scr, r, F.lane, MapId{}); continue; } r -= I_B5;
        if (r < I_B5) { tr_item(P.ssm, 512, D, D / 32, WT + W_SSM, scr, r, F.lane, MapId{}); continue; } r -= I_B5;
        if (r < I_B5) { tr_item(P.dsa, 512, D, D / 32, WT + W_DSA, scr, r, F.lane, MapId{}); continue; } r -= I_B5;
        if (r < I_B2) { tr_item(P.dil, 256, D, D / 32, WT + W_DIL, scr, r, F.lane, MapId{}); continue; } r -= I_B2;
        tr_item(P.glu, 512, 1024, 1024 / 32, WT + W_GLU, scr, r, F.lane, MapPair{512});
    }
}
__device__ __forceinline__ void cast_phase(const Frame& F, const float* x, bf16* xb) {
    const size_t n8 = (size_t)M * D / 8, stride = (size_t)F.G * NWAVES * 64;
    for (size_t i = (size_t)blockIdx.x * NWAVES * 64 + F.tid; i < n8; i += stride) {
        const f32x4 a = ((const GAS f32x4*)x)[2 * i], b = ((const GAS f32x4*)x)[2 * i + 1];
        v4u w; w.x = pk2(a.x, a.y); w.y = pk2(a.z, a.w); w.z = pk2(b.x, b.y); w.w = pk2(b.z, b.w);
        ((GAS v4u*)xb)[i] = w; }
}
__device__ __forceinline__ void ln_phase(const Frame& F, float* y, const float* g, const float* b, bf16* xb, f32x2v_* stat, int write_x) {
    const int gw = blockIdx.x * NWAVES + F.wave, NGW = F.G * NWAVES;
    f32x4 vn[8];
    if (gw < M) { const GAS f32x4* x0 = (const GAS f32x4*)(y + (size_t)gw * D) + F.lane;
#pragma unroll
        for (int j = 0; j < 8; ++j) vn[j] = x0[64 * j]; }
    for (int m = gw; m < M; m += NGW) {
        GAS f32x4* xr = (GAS f32x4*)(y + (size_t)m * D) + F.lane;
        f32x4 v[8]; float s = 0.f;
#pragma unroll
        for (int j = 0; j < 8; ++j) { v[j] = vn[j]; s += (v[j].x + v[j].y) + (v[j].z + v[j].w); }
        { const int mn = (m + NGW < M) ? m + NGW : m; const GAS f32x4* xn = (const GAS f32x4*)(y + (size_t)mn * D) + F.lane;
#pragma unroll
          for (int j = 0; j < 8; ++j) vn[j] = xn[64 * j]; }
        const float mean = wave_sum(s) * (1.f / D); float s2 = 0.f;
#pragma unroll
        for (int j = 0; j < 8; ++j) { v[j] = v[j] - mean; s2 += (v[j].x * v[j].x + v[j].y * v[j].y) + (v[j].z * v[j].z + v[j].w * v[j].w); }
        const float rstd = 1.f / sqrtf(wave_sum(s2) * (1.f / D) + LN_EPS);
        if (F.lane == 0) stat[m] = (f32x2v_){mean, rstd};
        GAS unsigned long long* o8 = (GAS unsigned long long*)(xb + (size_t)m * D) + F.lane;
#pragma unroll
        for (int j = 0; j < 8; ++j) { const f32x4 gg = ((const GAS f32x4*)g)[F.lane + 64 * j], bb = ((const GAS f32x4*)b)[F.lane + 64 * j];
            const f32x4 o = v[j] * rstd * gg + bb; if (write_x) xr[64 * j] = o;
            o8[64 * j] = (unsigned long long)pk2(o.x, o.y) | ((unsigned long long)pk2(o.z, o.w) << 32); }
    }
}

struct SsmPtrs { const float *lam_re, *lam_im, *log_dt, *b_re, *b_im, *c_re, *c_im, *dsk; };
__device__ __forceinline__ unsigned fkey(float x) { const unsigned b = __float_as_uint(x); return b ^ ((b >> 31) ? 0xFFFFFFFFu : 0x80000000u); }
typedef short bf16x8v __attribute__((ext_vector_type(8)));
typedef float f32x16 __attribute__((ext_vector_type(16)));
typedef float f32x2t __attribute__((ext_vector_type(2))); typedef __bf16 bf16x2t __attribute__((ext_vector_type(2)));
__device__ __forceinline__ unsigned cvtpk(float lo, float hi) { f32x2t v = {lo, hi}; bf16x2t b = __builtin_convertvector(v, bf16x2t); return __builtin_bit_cast(unsigned, b); }
#define MFMA32(a, b, c) __builtin_amdgcn_mfma_f32_32x32x16_bf16((a), (b), (c), 0, 0, 0)
__device__ __forceinline__ int crow(int r, int hi) { return (r & 3) + 8 * (r >> 2) + 4 * hi; }
__device__ __forceinline__ int pi32(int r) { return (r & 0x13) | ((r & 4) << 1) | ((r & 8) >> 1); }
constexpr int VTP = SEQ;
struct KVF { bf16x8v k[4], v[4]; };
__device__ __forceinline__ f32x16 qk_mma(const KVF& f, const bf16x8v (&qf)[4]) {
    f32x16 sT;
#pragma unroll
    for (int r = 0; r < 16; ++r) sT[r] = 0.f;
#pragma unroll
    for (int st = 0; st < 4; ++st) sT = MFMA32(f.k[st], qf[st], sT);
    return sT;
}
__device__ __forceinline__ void pv_mma_l(const float (&w)[16], const KVF& f, f32x16& O0, f32x16& O1, f32x16& Ol) {
    v4u p0, p1;
    p0.x = cvtpk(w[0], w[1]); p0.y = cvtpk(w[2], w[3]); p0.z = cvtpk(w[4], w[5]); p0.w = cvtpk(w[6], w[7]);
    p1.x = cvtpk(w[8], w[9]); p1.y = cvtpk(w[10], w[11]); p1.z = cvtpk(w[12], w[13]); p1.w = cvtpk(w[14], w[15]);
    const bf16x8v pa0 = __builtin_bit_cast(bf16x8v, p0), pa1 = __builtin_bit_cast(bf16x8v, p1);
    const bf16x8v ones = {0x3F80, 0x3F80, 0x3F80, 0x3F80, 0x3F80, 0x3F80, 0x3F80, 0x3F80};
    O0 = MFMA32(pa0, f.v[0], O0); O0 = MFMA32(pa1, f.v[1], O0);
    O1 = MFMA32(pa0, f.v[2], O1); O1 = MFMA32(pa1, f.v[3], O1);
    Ol = MFMA32(pa0, ones, Ol); Ol = MFMA32(pa1, ones, Ol);
}
__device__ __forceinline__ void pv_mma(const float (&w)[16], const KVF& f, f32x16& O0, f32x16& O1) {
    v4u p0, p1;
    p0.x = cvtpk(w[0], w[1]); p0.y = cvtpk(w[2], w[3]); p0.z = cvtpk(w[4], w[5]); p0.w = cvtpk(w[6], w[7]);
    p1.x = cvtpk(w[8], w[9]); p1.y = cvtpk(w[10], w[11]); p1.z = cvtpk(w[12], w[13]); p1.w = cvtpk(w[14], w[15]);
    const bf16x8v pa0 = __builtin_bit_cast(bf16x8v, p0), pa1 = __builtin_bit_cast(bf16x8v, p1);
    O0 = MFMA32(pa0, f.v[0], O0); O0 = MFMA32(pa1, f.v[1], O0);
    O1 = MFMA32(pa0, f.v[2], O1); O1 = MFMA32(pa1, f.v[3], O1);
}
struct KVG { v4u k[4], v[4]; };
constexpr int KV_KROW = 144, KV_VROW = 80, KV_V_OFF = 32 * KV_KROW, KV_BYTES = KV_V_OFF + 64 * KV_VROW;
__device__ __forceinline__ void kvg_load(KVG& g, const bf16* ktile  , size_t krow_stride  , const bf16* vtile  , int lane) {
#pragma unroll
    for (int j = 0; j < 4; ++j) g.k[j] = *(const GAS v4u*)(ktile + (size_t)((lane >> 3) + 8 * j) * krow_stride + 8 * (lane & 7));
#pragma unroll
    for (int j = 0; j < 4; ++j) g.v[j] = *(const GAS v4u*)(vtile + (size_t)((lane >> 2) + 16 * j) * VTP + 8 * (lane & 3));
}
__device__ __forceinline__ void kvg_store(const KVG& g, LAS unsigned char* img, int lane) {
#pragma unroll
    for (int j = 0; j < 4; ++j) *(LAS v4u*)(img + ((lane >> 3) + 8 * j) * KV_KROW + 16 * (lane & 7)) = g.k[j];
#pragma unroll
    for (int j = 0; j < 4; ++j) *(LAS v4u*)(img + KV_V_OFF + ((lane >> 2) + 16 * j) * KV_VROW + 16 * (lane & 3)) = g.v[j];
}
__device__ __forceinline__ void kvf_read(KVF& f, const LAS unsigned char* img, int n, int hi) {
    const LAS unsigned char* kp = img + pi32(n) * KV_KROW + 16 * hi;
#pragma unroll
    for (int st = 0; st < 4; ++st) f.k[st] = *(const LAS bf16x8v*)(kp + 32 * st);
    const LAS unsigned char* vp = img + KV_V_OFF + n * KV_VROW + 16 * hi;
#pragma unroll
    for (int db = 0; db < 2; ++db)
#pragma unroll
        for (int s = 0; s < 2; ++s) f.v[2 * db + s] = *(const LAS bf16x8v*)(vp + db * 32 * KV_VROW + 32 * s);
}
__device__ __forceinline__ void sb_mfma(const Frame& F, const bf16* Hc, const bf16* VTS, bf16* Y) {
    const int gw = blockIdx.x * NWAVES + F.wave, NGW = F.G * NWAVES, lane = F.lane, n = lane & 31, hi = lane >> 5;
    LAS unsigned char* img = F.lds + RING_OFF + F.wave * 16384;
    for (int it = gw; it < BC * 8 * 64; it += NGW) {
        const int qt = it & 63, h = (it >> 6) & 7, bl = it >> 9;
        const int q0 = qt * 32, t = q0 + n;
        const bf16* base = Hc + (size_t)bl * SEQ * HP;
        bf16x8v qf[4];
        { const bf16* qp = base + (size_t)t * HP + C_SBQ + h * 64 + 8 * hi;
#pragma unroll
          for (int st = 0; st < 4; ++st) qf[st] = *(const GAS bf16x8v*)(qp + 16 * st); }
        f32x16 O0, O1;
#pragma unroll
        for (int r = 0; r < 16; ++r) { O0[r] = 0.f; O1[r] = 0.f; }
        float R = 0.f;
        const bf16* kt0 = base + C_SBK + h * 64; const bf16* vt0 = VTS + (size_t)((bl * 8 + h) * 64) * VTP;
        { KVG g; kvg_load(g, kt0 + (size_t)(qt * 32) * HP, HP, vt0 + qt * 32, lane); kvg_store(g, img, lane); }
        for (int kt = qt; kt >= 0; --kt) {
            const int k0 = kt * 32;
            KVG g; { const int kn = kt > 0 ? kt - 1 : 0; kvg_load(g, kt0 + (size_t)(kn * 32) * HP, HP, vt0 + kn * 32, lane); }
            KVF cur; kvf_read(cur, img, n, hi);
            const f32x16 sT = qk_mma(cur, qf);
            float L[16], w[16];
#pragma unroll
            for (int r = 0; r < 16; ++r) { const int key = k0 + (r & 7) + 8 * hi + 16 * (r >> 3); const float z = sT[r];
                const float sp = fmaxf(z, 0.f) + lg2(1.f + ex2(-fabsf(z))); L[r] = (key < t) ? sp : 0.f; }
            float A0 = 0.f, A1 = 0.f;
#pragma unroll
            for (int r = 0; r < 8; ++r) { A0 += L[r]; A1 += L[8 + r]; }
            const float PA0 = __shfl_xor(A0, 32), PA1 = __shfl_xor(A1, 32);
            { float run = R + (hi ? 0.f : PA1);
#pragma unroll
              for (int r = 15; r >= 8; --r) { const int key = k0 + (r & 7) + 8 * hi + 16; w[r] = (key < t) ? ex2(sT[r] - L[r] - run) : 0.f; run += L[r]; }
              run = R + PA1 + A1 + (hi ? 0.f : PA0);
#pragma unroll
              for (int r = 7; r >= 0; --r) { const int key = k0 + r + 8 * hi; w[r] = (key < t) ? ex2(sT[r] - L[r] - run) : 0.f; run += L[r]; } }
            R += (A0 + A1) + (PA0 + PA1);
            v4u p0, p1;
            p0.x = cvtpk(w[0], w[1]); p0.y = cvtpk(w[2], w[3]); p0.z = cvtpk(w[4], w[5]); p0.w = cvtpk(w[6], w[7]);
            p1.x = cvtpk(w[8], w[9]); p1.y = cvtpk(w[10], w[11]); p1.z = cvtpk(w[12], w[13]); p1.w = cvtpk(w[14], w[15]);
            const bf16x8v pa0 = __builtin_bit_cast(bf16x8v, p0), pa1 = __builtin_bit_cast(bf16x8v, p1);
            O0 = MFMA32(pa0, cur.v[0], O0); O0 = MFMA32(pa1, cur.v[1], O0);
            O1 = MFMA32(pa0, cur.v[2], O1); O1 = MFMA32(pa1, cur.v[3], O1);
            if (__all(R >= 40.f)) break;
            kvg_store(g, img, lane);
        }
        bf16* yp = Y + (size_t)(bl * SEQ + q0) * 512 + h * 64 + n;
#pragma unroll
        for (int r = 0; r < 16; ++r) { bf16* rp = yp + (size_t)crow(r, hi) * 512; rp[0] = (bf16)f2bf(O0[r]); rp[32] = (bf16)f2bf(O1[r]); }
    }
}

__device__ __forceinline__ float row_ref(const f32x16& sT) {
    float a = sT[0];
#pragma unroll
    for (int r = 1; r < 16; ++r) a = fmaxf(a, sT[r]);
    return fmaxf(a, __shfl_xor(a, 32));
}
__device__ __forceinline__ void datt_mfma(const Frame& F, const bf16* Hc, const bf16* VTA, const unsigned* MASK32, bf16* Y, const float* rel_bias, LAS float* lut) {
    const int gw = blockIdx.x * NWAVES + F.wave, NGW = F.G * NWAVES, lane = F.lane, n = lane & 31, hi = lane >> 5;
    LAS unsigned char* img = F.lds + RING_OFF + F.wave * 16384;
    for (int i = F.tid; i < 8 * 128; i += NWAVES * 64) lut[i] = rel_bias[t5_bucket(i & 127) * 20 + 12 + (i >> 7)] * LOG2E;
    LDS_WAIT(); __syncthreads();
    for (int it = gw; it < BC * 8 * 32; it += NGW) {
        const int qp_ = it & 31, h = (it >> 5) & 7, bl = it >> 8;
        const bf16* base = Hc + (size_t)bl * SEQ * HP;
        const LAS float* lh = lut + h * 128;
        for (int half = 0; half < 2; ++half) {
            const int qt = half ? 63 - qp_ : qp_, q0 = qt * 32, t = q0 + n;
            bf16x8v qf[4];
            { const bf16* qp = base + (size_t)t * HP + C_AQ + h * 64 + 8 * hi;
#pragma unroll
              for (int st = 0; st < 4; ++st) qf[st] = *(const GAS bf16x8v*)(qp + 16 * st); }
            const bf16* kt0 = base + C_AK + h * 64; const bf16* vt0 = VTA + (size_t)((bl * 8 + h) * 64) * VTP;
            const unsigned* mrow = MASK32 + (size_t)(bl * SEQ + t) * 64;
            f32x16 O0, O1;
#pragma unroll
            for (int r = 0; r < 16; ++r) { O0[r] = 0.f; O1[r] = 0.f; }
            f32x16 Ol;
#pragma unroll
            for (int r = 0; r < 16; ++r) Ol[r] = 0.f;
            float mref = 0.f;
            { KVG g; kvg_load(g, kt0, HP, vt0, lane); kvg_store(g, img, lane); } unsigned mw = mrow[0];
            for (int kt = 0; kt <= qt; ++kt) {
                const int k0 = kt * 32;
                KVG g; const int kn = kt < qt ? kt + 1 : qt; kvg_load(g, kt0 + (size_t)(kn * 32) * HP, HP, vt0 + kn * 32, lane); const unsigned mwn = mrow[kn];
                KVF cur; kvf_read(cur, img, n, hi);
                const f32x16 sT = qk_mma(cur, qf);
                if (kt == 0) mref = row_ref(sT);
                float w[16];
                const unsigned mwh = mw >> (8 * hi);
                if (k0 + 31 + 113 <= q0) {
                    const float cb = lh[127] - mref;
#pragma unroll
                    for (int r = 0; r < 16; ++r) { const float p = ex2(sT[r] + cb); const unsigned sel = (unsigned)__builtin_amdgcn_sbfe((int)mwh, (r & 7) + 16 * (r >> 3), 1);
                        w[r] = __uint_as_float(__float_as_uint(p) & sel); }
                } else {
#pragma unroll
                    for (int r = 0; r < 16; ++r) { const int ko = (r & 7) + 8 * hi + 16 * (r >> 3); int dist = t - (k0 + ko); dist = dist < 0 ? 0 : (dist > 127 ? 127 : dist);
                        const float p = ex2(sT[r] + lh[dist] - mref); w[r] = ((mwh >> ((r & 7) + 16 * (r >> 3))) & 1u) ? p : 0.f; }
                }
                pv_mma_l(w, cur, O0, O1, Ol);
                kvg_store(g, img, lane); mw = mwn;
            }
            bf16* yp = Y + (size_t)(bl * SEQ + q0 + 4 * hi) * 512 + h * 64 + n;
#pragma unroll
            for (int r = 0; r < 16; ++r) { const int ro = (r & 3) + 8 * (r >> 2); const float rr = 1.f / Ol[r]; bf16* rp = yp + (size_t)ro * 512; rp[0] = (bf16)f2bf(O0[r] * rr); rp[32] = (bf16)f2bf(O1[r] * rr); }
        }
    }
    __syncthreads();
}

__device__ __forceinline__ void dil_mfma(const Frame& F, const bf16* Hc, const bf16* VTD, bf16* Y, const float* rel_bias, LAS float* lut) {
    const int gw = blockIdx.x * NWAVES + F.wave, NGW = F.G * NWAVES, lane = F.lane, n = lane & 31, hi = lane >> 5;
    LAS unsigned char* img = F.lds + RING_OFF + F.wave * 16384;
    for (int i = F.tid; i < 12 * 132; i += NWAVES * 64) { const int d = i % 132, gh = i / 132, g = gh >> 2; lut[i] = (d <= 128) ? rel_bias[t5_bucket(d << (2 * g)) * 20 + gh] * LOG2E : 0.f; }
    LDS_WAIT(); __syncthreads();
    for (int it = gw; it < BC * 4 * 16 * 4; it += NGW) {
        const int ib = it & 3, c16 = (it >> 2) & 15, hs = (it >> 6) & 3, bl = it >> 8;
        const bf16* base = Hc + (size_t)bl * SEQ * HP;
        f32x16 O0, O1;
#pragma unroll
        for (int r = 0; r < 16; ++r) { O0[r] = 0.f; O1[r] = 0.f; }
        f32x16 Ol;
#pragma unroll
        for (int r = 0; r < 16; ++r) Ol[r] = 0.f;
        float mref = 0.f; bool first = true;
        for (int g = 2; g >= 0; --g) {
            const int sh = 2 * g, r_ = 1 << sh, head = g * 4 + hs, cls = c16 & (r_ - 1);
            const int pq0 = (c16 >> sh) + (16 >> sh) * 32 * ib, pstep = 16 >> sh;
            const int pq = pq0 + pstep * n, tq = c16 + 16 * (32 * ib + n);
            bf16x8v qf[4];
            { const bf16* qp = base + (size_t)tq * HP + C_DQ + head * 64 + 8 * hi;
#pragma unroll
              for (int st = 0; st < 4; ++st) qf[st] = *(const GAS bf16x8v*)(qp + 16 * st); }
            const bf16* kt0 = base + (size_t)cls * HP + C_DK + head * 64;
            const bf16* vt0 = VTD + (size_t)((bl * 12 + head) * 64) * VTP + cls * (SEQ >> sh);
            const LAS float* lh = lut + head * 132;
            int klo = pq0 - 128; klo = klo < 0 ? 0 : (klo >> 5);
            const int khi = (pq0 + pstep * 31) >> 5;
            { KVG g; kvg_load(g, kt0 + (size_t)(r_ * klo * 32) * HP, (size_t)r_ * HP, vt0 + klo * 32, lane); kvg_store(g, img, lane); }
            for (int kt = klo; kt <= khi; ++kt) {
                const int k0 = kt * 32;
                KVG g; { const int kn = kt < khi ? kt + 1 : khi; kvg_load(g, kt0 + (size_t)(r_ * kn * 32) * HP, (size_t)r_ * HP, vt0 + kn * 32, lane); }
                KVF cur; kvf_read(cur, img, n, hi);
                const f32x16 sT = qk_mma(cur, qf);
                if (first) { mref = row_ref(sT); first = false; }
                float w[16];
#pragma unroll
                for (int r = 0; r < 16; ++r) { const int ko = (r & 7) + 8 * hi + 16 * (r >> 3); const int dist = pq - (k0 + ko); const bool valid = (dist >= 0) && (dist <= 128);
                    const int dc = dist < 0 ? 0 : (dist > 128 ? 128 : dist);
                    const float p = ex2(sT[r] + lh[dc] - mref); w[r] = valid ? p : 0.f; }
                pv_mma_l(w, cur, O0, O1, Ol);
                kvg_store(g, img, lane);
            }
        }
        bf16* yp = Y + (size_t)(bl * SEQ + c16 + 512 * ib + 64 * hi) * 256 + hs * 64 + n;
#pragma unroll
        for (int r = 0; r < 16; ++r) { const int ro = (r & 3) + 8 * (r >> 2); const float rr = 1.f / Ol[r]; bf16* rp = yp + (size_t)(16 * ro) * 256; rp[0] = (bf16)f2bf(O0[r] * rr); rp[32] = (bf16)f2bf(O1[r] * rr); }
    }
    __syncthreads();
}

__device__ __forceinline__ void dsel_mfma(const Frame& F, const bf16* Hc, unsigned* MASK32, LAS unsigned* part  , LAS unsigned char* qimg  ) {
    const int lane = F.lane, n = lane & 31, hi = lane >> 5, w = F.wave;
    for (int i_ = blockIdx.x * (NWAVES * 64) + F.tid; ; i_ += F.G * NWAVES * 64) { int i = i_; asm volatile("" : "+v"(i)); if (i >= BC * 256 * 8) break;
        const int word = i & 7, t = (i >> 3) & 255, bl = i >> 11; const int nb = t + 1 - 32 * word;
        MASK32[(size_t)(bl * SEQ + t) * 64 + word] = nb >= 32 ? 0xFFFFFFFFu : (nb <= 0 ? 0u : ((1u << nb) - 1u)); }
    int pp = 0; LAS unsigned* hist = part + 512;
#define WG_REDUCE(cexpr, out) do { unsigned c_ = (cexpr); c_ += __shfl_xor(c_, 32); if (hi == 0) part[pp * 256 + w * 32 + n] = c_; LDS_WAIT(); __syncthreads(); unsigned t_ = 0; \
        _Pragma("unroll") for (int ww = 0; ww < 8; ++ww) t_ += part[pp * 256 + ww * 32 + n]; out = t_; pp ^= 1; } while (0)
    for (int u = blockIdx.x; u < BC * 56; u += F.G) {
        const int qt = (u < 256) ? 63 - (u >> 3) : 8 + ((u - 256) >> 3), bl = u & 7;
        const int q0 = 32 * qt, t = q0 + n;
        const bf16* base = Hc + (size_t)bl * SEQ * HP;
        const bf16* qrow = base + (size_t)t * HP;
        const bf16* kb = base + (size_t)pi32(n) * HP + C_IK + 8 * hi;
        const int ntl = ((qt - w) >> 3) + 1;
        __syncthreads();
        for (int i = F.tid; i < 2 * 544; i += NWAVES * 64) hist[i] = 0u;
        { const int qq = F.tid >> 4, part4 = F.tid & 15; const bf16* src = base + (size_t)(q0 + qq) * HP + C_IQ + part4 * 32; LAS unsigned char* dq = qimg + qq * 1040 + part4 * 64;
#pragma unroll
          for (int k = 0; k < 4; ++k) *(LAS v4u*)(dq + 16 * k) = *(const GAS v4u*)(src + 8 * k); }
        if (F.tid < 32) { float wq[8]; ld8(base + (size_t)(q0 + F.tid) * HP + C_IW, wq); LAS float* wd = (LAS float*)(qimg + 33280) + F.tid * 9;
#pragma unroll
          for (int k = 0; k < 8; ++k) wd[k] = wq[k]; }
        LDS_WAIT(); __syncthreads();
        const LAS float* wl = (const LAS float*)(qimg + 33280) + n * 9;
        float sc[8][16];
#pragma unroll
        for (int i = 0; i < 8; ++i)
#pragma unroll
            for (int r = 0; r < 16; ++r) sc[i][r] = 0.f;
        const LAS unsigned char* qb = qimg + n * 1040 + 16 * hi;
        bf16x8v kc[4];
#pragma unroll
        for (int st = 0; st < 4; ++st) kc[st] = *(const GAS bf16x8v*)(kb + (size_t)(32 * w) * HP + 16 * st);
#pragma unroll
        for (int i = 0; i < 8; ++i) if (i < ntl) {
            bf16x8v kn[4]; { const int in = (i + 1 < ntl) ? i + 1 : i;
#pragma unroll
              for (int st = 0; st < 4; ++st) kn[st] = *(const GAS bf16x8v*)(kb + (size_t)(32 * (w + 8 * in)) * HP + 16 * st); }
#pragma unroll
            for (int hh = 0; hh < 8; ++hh) {
                f32x16 sT;
#pragma unroll
                for (int r = 0; r < 16; ++r) sT[r] = 0.f;
#pragma unroll
                for (int st = 0; st < 4; ++st) { const bf16x8v qf = *(const LAS bf16x8v*)(qb + hh * 128 + st * 32); sT = MFMA32(kc[st], qf, sT); }
                const float wh = wl[hh];
#pragma unroll
                for (int r = 0; r < 16; ++r) sc[i][r] += wh * fmaxf(sT[r], 0.f);
            }
#pragma unroll
            for (int st = 0; st < 4; ++st) kc[st] = kn[st];
        }
        unsigned key[8][16];
        int pbase = 8 * hi + 32 * w; asm volatile("" : "+v"(pbase));
        const int lim = t - pbase;
#pragma unroll
        for (int i = 0; i < 8; ++i)
#pragma unroll
            for (int r = 0; r < 16; ++r) key[i][r] = (i < ntl && (256 * i + (r & 7) + 16 * (r >> 3)) <= lim) ? fkey(sc[i][r] + 0.f) : 0u;
        unsigned tau = 0u; int above = 0, ceq = 0;
#pragma unroll 1
        for (int ps = 0; ps < 8; ++ps) {
            const int s = 28 - 4 * ps; LAS unsigned* hb = hist + (ps % 3) * 544 + n;
#pragma unroll
            for (int i = 0; i < 8; ++i) if (i < ntl) {
#pragma unroll
                for (int r = 0; r < 16; ++r) { const unsigned k = key[i][r]; const bool match = ((k >> s) >> 4) == tau; const unsigned bin = match ? ((k >> s) & 15u) : 16u;
                    (void)__hip_atomic_fetch_add(hb + bin * 32, 1u, __ATOMIC_RELAXED, __HIP_MEMORY_SCOPE_WORKGROUP); } }
            LDS_WAIT(); __syncthreads();
            { LAS unsigned* hz = hist + ((ps + 2) % 3) * 544; for (int i = F.tid; i < 544; i += NWAVES * 64) hz[i] = 0u; }
            int cum = above, chosen = 0, hsel = 0; bool found = false;
#pragma unroll
            for (int b = 15; b >= 0; --b) { const int h = (int)hb[b * 32]; const bool hit = !found && (cum + h >= 256); chosen = hit ? b : chosen; hsel = hit ? h : hsel; found = found || hit; cum += found ? 0 : h; }
            above = cum; ceq = hsel; tau = (tau << 4) | (unsigned)chosen;
        }
        const int need = 256 - above;
        unsigned anyw = (unsigned)__any(ceq != need);
        int X = 4096;
        if (anyw) {
            X = 0;
            for (int b = 11; b >= 0; --b) {
                const int Xc = X | (1 << b), Xl = Xc - pbase; unsigned c = 0u;
#pragma unroll
                for (int i = 0; i < 8; ++i) if (i < ntl) {
#pragma unroll
                    for (int r = 0; r < 16; ++r) c += (key[i][r] == tau && (256 * i + (r & 7) + 16 * (r >> 3)) < Xl) ? 1u : 0u; }
                unsigned tot; WG_REDUCE(c, tot);
                if ((int)tot <= need) X = Xc;
            }
        }
        const int Xf = X - pbase;
#pragma unroll
        for (int i = 0; i < 8; ++i) if (i < ntl) {
            unsigned word = 0u;
#pragma unroll
            for (int r = 0; r < 16; ++r) { const bool sel = (key[i][r] > tau) || (key[i][r] == tau && (256 * i + (r & 7) + 16 * (r >> 3)) < Xf); word |= sel ? (1u << ((r & 7) + 16 * (r >> 3))) : 0u; }
            word <<= 8 * hi;
            word |= __shfl_xor(word, 32);
            if (hi == 0) MASK32[(size_t)(bl * SEQ + t) * 64 + (w + 8 * i)] = word;
        }
    }
#undef WG_REDUCE
}

constexpr size_t SSM_APOW = 0, SSM_BT = 576 * 1024, SSM_KT = 832 * 1024, SSM_GT = 2 * MiB, SSM_HT = 6 * MiB;
typedef float f32x2v __attribute__((ext_vector_type(2)));
__device__ __forceinline__ void apow_phase(const Frame& F, const SsmPtrs& S, unsigned char* T) {
    f32x2v* APOW = (f32x2v*)(T + SSM_APOW); f32x2v* BT = (f32x2v*)(T + SSM_BT);
    const int gtid = blockIdx.x * (NWAVES * 64) + F.tid, NT = F.G * NWAVES * 64;
    for (int e = gtid; e < 32 * 33 * 64; e += NT) { const int p = e & 63, k = (e >> 6) % 33, g = e / (33 * 64);
        const float lr = S.lam_re[g * 64 + p], li = S.lam_im[g * 64 + p], dt = expf(S.log_dt[g]);
        const float mag = expf((float)k * (lr * dt)), ang = (float)k * (li * dt); APOW[e] = (f32x2v){mag * cosf(ang), mag * sinf(ang)}; }
    for (int e = gtid; e < 32 * 64 * 16; e += NT) { const int p = (e >> 4) & 63, g = e >> 10;
        const float lr = S.lam_re[g * 64 + p], li = S.lam_im[g * 64 + p], dt = expf(S.log_dt[g]);
        const float mag = expf(lr * dt), a_re = mag * cosf(li * dt), a_im = mag * sinf(li * dt);
        const float den = lr * lr + li * li, f_re = ((a_re - 1.f) * lr + a_im * li) / den, f_im = (a_im * lr - (a_re - 1.f) * li) / den;
        const float br = S.b_re[e], bi = S.b_im[e]; BT[e] = (f32x2v){f_re * br - f_im * bi, f_re * bi + f_im * br}; }
}
__device__ __forceinline__ void ssm_tables_phase(const Frame& F, const SsmPtrs& S, unsigned char* T) {
    const f32x2v* APOW = (const f32x2v*)(T + SSM_APOW); const f32x2v* BT = (const f32x2v*)(T + SSM_BT);
    bf16* KT = (bf16*)(T + SSM_KT); bf16* GT = (bf16*)(T + SSM_GT); bf16* HT = (bf16*)(T + SSM_HT);
    const int gtid = blockIdx.x * (NWAVES * 64) + F.tid, NT = F.G * NWAVES * 64;
    for (int e = gtid; e < 32 * 32 * 128 * 16; e += NT) {
        const int c = e & 15, pp = (e >> 4) & 127, sig = (e >> 11) & 31, g = e >> 16, p = pp & 63;
        const f32x2v ap = APOW[(g * 33 + (31 - sig)) * 64 + p], bt = BT[(g * 64 + p) * 16 + c];
        GT[e] = (bf16)f2bf((pp >> 6) ? (ap.x * bt.y + ap.y * bt.x) : (ap.x * bt.x - ap.y * bt.y)); }
    for (int e = gtid; e < 32 * 32 * 16 * 128; e += NT) {
        const int k = e & 127, c = (e >> 7) & 15, tau = (e >> 11) & 31, g = e >> 16, p = k & 63;
        const f32x2v ap = APOW[(g * 33 + tau + 1) * 64 + p]; const float cr = S.c_re[(g * 16 + c) * 64 + p], ci = S.c_im[(g * 16 + c) * 64 + p];
        HT[e] = (bf16)f2bf((k >> 6) ? -(cr * ap.y + ci * ap.x) : (cr * ap.x - ci * ap.y)); }
    for (int e = gtid; e < 32 * 32 * 16 * 16; e += NT) {
        const int c2 = e & 15, c = (e >> 4) & 15, k = (e >> 8) & 31, g = e >> 13; float acc = 0.f;
        for (int p = 0; p < 64; ++p) { const f32x2v ap = APOW[(g * 33 + k) * 64 + p], bt = BT[(g * 64 + p) * 16 + c2]; const float cr = S.c_re[(g * 16 + c) * 64 + p], ci = S.c_im[(g * 16 + c) * 64 + p];
            const float mr = ap.x * bt.x - ap.y * bt.y, mi = ap.x * bt.y + ap.y * bt.x; acc += cr * mr - ci * mi; }
        KT[e] = (bf16)f2bf(acc); }
}
constexpr int SSM_UROW = 1040, SSM_U_OFF = 0, SSM_P_OFF = 64 * SSM_UROW, SSM_PROW = 516, SSM_S_OFF = SSM_P_OFF + 64 * SSM_PROW, SSM_SROW = 272;
static_assert(SSM_S_OFF % 16 == 0 && SSM_S_OFF + 64 * SSM_SROW <= RING_BYTES, "ssm LDS map");
__device__ __forceinline__ void ssm_mfma(const Frame& F, const bf16* Hc, bf16* YG, const float* dskip, const unsigned char* T) {
    const int lane = F.lane, n = lane & 31, hi = lane >> 5, w = F.wave;
    LAS unsigned char* L = F.lds + RING_OFF;
    const f32x2v* APOW = (const f32x2v*)(T + SSM_APOW);
    for (int u = blockIdx.x; u < BC * 32; u += F.G) {
        const int g = u & 31, bl = u >> 5;
        const bf16* KT = (const bf16*)(T + SSM_KT) + (size_t)g * 32 * 256; const bf16* GT = (const bf16*)(T + SSM_GT) + (size_t)g * 65536; const bf16* HT = (const bf16*)(T + SSM_HT) + (size_t)g * 65536;
#pragma unroll
        for (int k = 0; k < 4; ++k) { const int tok = F.tid + 512 * k; const bf16* up = Hc + (size_t)(bl * SEQ + tok) * HP + C_U + 16 * g;
            const v4u a = *(const GAS v4u*)up, b = *(const GAS v4u*)(up + 8); LAS unsigned char* d = L + SSM_U_OFF + (tok >> 5) * SSM_UROW + (tok & 31) * 32;
            *(LAS v4u*)d = a; *(LAS v4u*)(d + 16) = b; }
        LDS_WAIT(); __syncthreads();
        { const int rt = w >> 1, ct = w & 1; f32x16 acc;
#pragma unroll
          for (int r = 0; r < 16; ++r) acc[r] = 0.f;
          const bf16* gp = GT + (size_t)(32 * rt + n) * 16 + 8 * hi; const LAS unsigned char* ub = L + SSM_U_OFF + (32 * ct + n) * SSM_UROW + 16 * hi;
#pragma unroll 8
          for (int sig = 0; sig < 32; ++sig) { const bf16x8v a = *(const GAS bf16x8v*)(gp + (size_t)sig * 2048); const bf16x8v b = *(const LAS bf16x8v*)(ub + sig * 32); acc = MFMA32(a, b, acc); }
          LAS float* pl = (LAS float*)(L + SSM_P_OFF + (32 * ct + n) * SSM_PROW) + 32 * rt;
#pragma unroll
          for (int r = 0; r < 16; ++r) pl[crow(r, hi)] = acc[r]; }
        LDS_WAIT(); __syncthreads();
        if (w == 0) { const f32x2v a32 = APOW[(g * 33 + 32) * 64 + lane]; float sr = 0.f, si = 0.f;
            for (int j = 0; j < 64; ++j) { LAS bf16* sl = (LAS bf16*)(L + SSM_S_OFF + j * SSM_SROW); sl[lane] = (bf16)f2bf(sr); sl[64 + lane] = (bf16)f2bf(si);
                const LAS float* pl = (const LAS float*)(L + SSM_P_OFF + j * SSM_PROW); const float pr = pl[lane], pi = pl[64 + lane];
                const float nr = a32.x * sr - a32.y * si + pr, ni = a32.x * si + a32.y * sr + pi; sr = nr; si = ni; } }
        LDS_WAIT(); __syncthreads();
#pragma unroll 1
        for (int q = 0; q < 4; ++q) {
            const int rt = (q < 2) ? w : 15 - w, ct = q & 1; f32x16 acc;
#pragma unroll
            for (int r = 0; r < 16; ++r) acc[r] = 0.f;
            const int tl = 2 * rt + (n >> 4), cl = n & 15;
            const LAS unsigned char* ub = L + SSM_U_OFF + (32 * ct + n) * SSM_UROW + 16 * hi;
            const bf16* kp = KT + cl * 16 + 8 * hi;
            for (int sig = 0; sig <= 2 * rt + 1; ++sig) { const int lag = tl - sig; bf16x8v a = *(const GAS bf16x8v*)(kp + (size_t)(lag < 0 ? 0 : lag) * 256);
                if (lag < 0) a = (bf16x8v){0, 0, 0, 0, 0, 0, 0, 0};
                const bf16x8v b = *(const LAS bf16x8v*)(ub + sig * 32); acc = MFMA32(a, b, acc); }
            const bf16* hp = HT + (size_t)(tl * 16 + cl) * 128 + 8 * hi; const LAS unsigned char* sb = L + SSM_S_OFF + (32 * ct + n) * SSM_SROW + 16 * hi;
#pragma unroll
            for (int ks = 0; ks < 8; ++ks) { const bf16x8v a = *(const GAS bf16x8v*)(hp + 16 * ks); const bf16x8v b = *(const LAS bf16x8v*)(sb + 32 * ks); acc = MFMA32(a, b, acc); }
            const f32x4 d0 = *(const GAS f32x4*)(dskip + 16 * g + 4 * hi), d1 = *(const GAS f32x4*)(dskip + 16 * g + 8 + 4 * hi);
            const LAS unsigned short* uimg = (const LAS unsigned short*)(L + SSM_U_OFF + (32 * ct + n) * SSM_UROW);
#pragma unroll
            for (int half = 0; half < 2; ++half)
#pragma unroll
                for (int cq = 0; cq < 2; ++cq) {
                    float o[4];
#pragma unroll
                    for (int i = 0; i < 4; ++i) { const int r = 8 * half + 4 * cq + i; const int tau = 2 * rt + half, c = i + 8 * cq + 4 * hi;
                        const float uu = __uint_as_float((unsigned)uimg[tau * 16 + c] << 16); const float dd = cq ? d1[i] : d0[i];
                        const float y = acc[r] + dd * uu; const float z = 0.7978845608028654f * (y + 0.044715f * y * y * y);
                        const float th = 1.f - 2.f * __builtin_amdgcn_rcpf(1.f + ex2(2.f * LOG2E * z)); o[i] = 0.5f * y * (1.f + th); }
                    const unsigned long long wv = (unsigned long long)pk2(o[0], o[1]) | ((unsigned long long)pk2(o[2], o[3]) << 32);
                    *(GAS unsigned long long*)(YG + (size_t)(bl * SEQ + 32 * (32 * ct + n) + 2 * rt + half) * 512 + 16 * g + 8 * cq + 4 * hi) = wv; }
        }
        LDS_WAIT(); __syncthreads();
    }
}
__device__ __forceinline__ bool stage_enter(Frame& F) { int l_; asm volatile("v_mbcnt_lo_u32_b32 %0, -1, 0\n\tv_mbcnt_hi_u32_b32 %0, -1, %0" : "=v"(l_)); F.lane = l_; F.tid = F.wave * 64 + l_; return true; }
struct Args { const float* in[23]; float* out; unsigned char* ws; int lo, hi, use_bar, pad; };
__global__ void __launch_bounds__(NWAVES * 64, 2) fwd_kernel(Args args) {
    extern __shared__ __attribute__((aligned(16))) unsigned char lds[];
    Frame F;
    F.lds = (LAS unsigned char*)lds; F.tid = threadIdx.x; F.lane = F.tid & 63; F.wave = __builtin_amdgcn_readfirstlane(F.tid >> 6); F.G = gridDim.x;
    volatile LAS unsigned* MISC = (volatile LAS unsigned*)(F.lds + MISC_OFF);
    unsigned char* ws = args.ws;
    gu32* ctl = (gu32*)(ws + WS_CTL);
    for (int u = F.tid; u < (LDS_BYTES - LDSCTL_OFF) / 4; u += NWAVES * 64) ((LAS unsigned*)(F.lds + LDSCTL_OFF))[u] = 0u;
    __syncthreads();
    XcdBarrier bar; bar.bar = (unsigned*)(ctl + CW_BAR); bar.x = 0; bar.st = nullptr;
    if (args.use_bar) bar = xcd_barrier_post((unsigned*)(ctl + CW_BAR), MISC + 8);
    const int lo = args.lo, hi = args.hi;
    int st = 0;
#define STAGE_IF (lo <= st && st < hi && stage_enter(F))
#define STAGE_END do { if (st + 1 < hi) { xcd_barrier(bar); } } while (0)
    bf16* WT = (bf16*)(ws + WS_WT); bf16* XB = (bf16*)(ws + WS_XB); bf16* MG = (bf16*)(ws + WS_MG); bf16* HB = (bf16*)(ws + WS_H);
    bf16* YSB = (bf16*)(ws + WS_YSB); bf16* YDIL = (bf16*)(ws + WS_YDIL); bf16* YSSM = (bf16*)(ws + WS_YSSM); bf16* YDSA = (bf16*)(ws + WS_YDSA); bf16* YG = (bf16*)(ws + WS_YG);
    unsigned long long* MASK = (unsigned long long*)(ws + WS_MASK);
    bf16* GTL = (bf16*)(ws + WS_GT);
    bf16* VTS = (bf16*)(ws + WS_VTS); bf16* VTD = (bf16*)(ws + WS_VTD); bf16* VTA = (bf16*)(ws + WS_VTA);
    float* X = args.out;
    const float* rel_bias = args.in[6];

    for (int layer = 0; layer < DEPTH; ++layer) {
        if (STAGE_IF) {
            WPtrs P; P.up1 = args.in[3] + (size_t)layer * D * NUP; P.dn1 = args.in[4] + (size_t)layer * DFF * D; P.win = args.in[5] + (size_t)layer * D * INC;
            P.glu = args.in[15] + (size_t)layer * 512 * 1024; P.sb = args.in[16] + (size_t)layer * 512 * D; P.dil = args.in[17] + (size_t)layer * 256 * D; P.ssm = args.in[18] + (size_t)layer * 512 * D;
            P.dsa = args.in[19] + (size_t)layer * 512 * D; P.wout = args.in[20] + (size_t)layer * D * D; P.up2 = args.in[21] + (size_t)layer * D * NUP; P.dn2 = args.in[22] + (size_t)layer * DFF * D;
            weights_phase(F, P, WT);
            { SsmPtrs SP; SP.lam_re = args.in[7] + layer * 2048; SP.lam_im = args.in[8] + layer * 2048; SP.log_dt = args.in[9] + layer * 32; SP.b_re = args.in[10] + layer * 32768; SP.b_im = args.in[11] + layer * 32768;
              SP.c_re = args.in[12] + layer * 32768; SP.c_im = args.in[13] + layer * 32768; SP.dsk = args.in[14] + layer * 512; apow_phase(F, SP, ws + WS_SSMT); }
            if (layer == 0) cast_phase(F, args.in[0], XB);
            STAGE_END;
        }
        ++st;
        for (int s = 0; s < 3; ++s) {
            if (s != 1) {
                if (STAGE_IF) {
                    pg8::Gemm g{XB, WT + (s == 0 ? W_1U : W_2U), M, NUP, D}; pg8::StaticOrder S; S.init(M, NUP, F.G, (int)blockIdx.x, WGM_UP);
                    pg8::EpiPair<0> E{HB, DFF};
                    pg8::gemm_phase<pg8::EpiPair<0>, pg8::StaticOrder, true, true>(F.lds + RING_OFF, g, S, E, F.tid);
                    STAGE_END;
                }
                ++st;
            } else {
                for (int c = 0; c < NCH; ++c) {
                    const size_t r0 = (size_t)c * MC;
                    if (STAGE_IF) {
                        pg8::Gemm g{XB + r0 * D, WT + W_IN, MC, NH, D}; pg8::StaticOrder S; S.init(MC, NH, F.G, (int)blockIdx.x, WGM_UP);
                        pg8::EpiH E{HB, HP, GATE_T0, GTL, VTS, VTD, VTA};
                        pg8::gemm_phase<pg8::EpiH, pg8::StaticOrder, true, true>(F.lds + RING_OFF, g, S, E, F.tid);
                        STAGE_END;
                    }
                    ++st;
                    if (STAGE_IF) {
                        {
                        __syncthreads();
                        ssm_mfma(F, HB, YG, args.in[14] + layer * 512, ws + WS_SSMT);
                        dsel_mfma(F, HB, (unsigned*)MASK, (LAS unsigned*)(F.lds + LDSCTL_OFF + 1024), F.lds + RING_OFF);
                        __syncthreads(); }
                        STAGE_END;
                    }
                    ++st;
                    if (STAGE_IF) {
                        __syncthreads();
                        { pg8::Gemm g{YG, WT + W_GLU, MC, 1024, 512}; pg8::StaticOrder S; S.init(MC, 1024, F.G, (int)blockIdx.x);
                          pg8::EpiPair<1> E{YSSM, 512};
                          pg8::gemm_phase<pg8::EpiPair<1>, pg8::StaticOrder, true, true>(F.lds + RING_OFF, g, S, E, F.tid); }
                        __syncthreads();
                        {
                        sb_mfma(F, HB, VTS, YSB);
                        dil_mfma(F, HB, VTD, YDIL, rel_bias, (LAS float*)(F.lds + LDSCTL_OFF + 9984));
                        datt_mfma(F, HB, VTA, (const unsigned*)MASK, YDSA, rel_bias, (LAS float*)(F.lds + LDSCTL_OFF + 1024));
                        }
                        STAGE_END;
                    }
                    ++st;
                    if (STAGE_IF) {
                        bf16* MGc = MG + r0 * D;
                        { pg8::Gemm g{YSB, WT + W_SB, MC, D, 512}; pg8::StaticOrder S; S.init(MC, D, F.G, (int)blockIdx.x); pg8::EpiGateAcc E{GTL, 0, MGc, D, 1};
                          pg8::gemm_phase<pg8::EpiGateAcc, pg8::StaticOrder, true, true>(F.lds + RING_OFF, g, S, E, F.tid); }
                        __syncthreads();
                        { pg8::Gemm g{YDIL, WT + W_DIL, MC, D, 256}; pg8::StaticOrder S; S.init(MC, D, F.G, (int)blockIdx.x); pg8::EpiGateAcc E{GTL, 1, MGc, D, 0};
                          pg8::gemm_phase<pg8::EpiGateAcc, pg8::StaticOrder, true, true>(F.lds + RING_OFF, g, S, E, F.tid); }
                        __syncthreads();
                        { pg8::Gemm g{YSSM, WT + W_SSM, MC, D, 512}; pg8::StaticOrder S; S.init(MC, D, F.G, (int)blockIdx.x); pg8::EpiGateAcc E{GTL, 2, MGc, D, 0};
                          pg8::gemm_phase<pg8::EpiGateAcc, pg8::StaticOrder, true, true>(F.lds + RING_OFF, g, S, E, F.tid); }
                        __syncthreads();
                        { pg8::Gemm g{YDSA, WT + W_DSA, MC, D, 512}; pg8::StaticOrder S; S.init(MC, D, F.G, (int)blockIdx.x); pg8::EpiGateAcc E{GTL, 3, MGc, D, 0};
                          pg8::gemm_phase<pg8::EpiGateAcc, pg8::StaticOrder, true, true>(F.lds + RING_OFF, g, S, E, F.tid); }
                        STAGE_END;
                    }
                    ++st;
                }
            }
            if (STAGE_IF) {
                const bf16* A = (s == 1) ? MG : HB; const bf16* Bt = WT + (s == 0 ? W_1D : (s == 1 ? W_OUT : W_2D)); const int K = (s == 1) ? D : DFF;
                pg8::Gemm g{A, Bt, M, D, K}; pg8::StaticOrder S; S.init(M, D, F.G, (int)blockIdx.x);
                const int first = (layer == 0 && s == 0), pidx = layer * 3 + s - 1;
                pg8::EpiResid E{first ? args.in[0] : X, X, (const pg8::f32x2e*)(ws + WS_STAT), args.in[1] + (size_t)(first ? 0 : pidx) * D, args.in[2] + (size_t)(first ? 0 : pidx) * D, D, first ? 0 : 1, DN_ALPHA, (s == 1) ? 1.0f : 0.5f};
                pg8::gemm_phase<pg8::EpiResid, pg8::StaticOrder, true, true>(F.lds + RING_OFF, g, S, E, F.tid);
                STAGE_END;
            }
            ++st;
            if (STAGE_IF) {
                ln_phase(F, X, args.in[1] + (size_t)(layer * 3 + s) * D, args.in[2] + (size_t)(layer * 3 + s) * D, XB, (f32x2v_*)(ws + WS_STAT), (layer == DEPTH - 1 && s == 2) ? 1 : 0);
                if (s == 0) { SsmPtrs SP; SP.lam_re = args.in[7] + layer * 2048; SP.lam_im = args.in[8] + layer * 2048; SP.log_dt = args.in[9] + layer * 32; SP.b_re = args.in[10] + layer * 32768; SP.b_im = args.in[11] + layer * 32768;
                  SP.c_re = args.in[12] + layer * 32768; SP.c_im = args.in[13] + layer * 32768; SP.dsk = args.in[14] + layer * 512; ssm_tables_phase(F, SP, ws + WS_SSMT); }
                STAGE_END;
            }
            ++st;
        }
    }
#undef STAGE_IF
#undef STAGE_END
}
constexpr int N_STAGES = DEPTH * 17;

extern "C" void kernel_launch(void* const* d_in, const int* in_sizes, int n_in, void* d_out, int out_size, void* d_ws, size_t ws_size, hipStream_t stream) {
    static int grid = 0;
    if (grid == 0) {
        if (n_in != 23 || in_sizes[0] != M * D || out_size != M * D || ws_size < WS_END) { fprintf(stderr, "kernel_launch: unexpected shapes / workspace (n_in %d, in0 %d, out %d, ws %zu, need %zu)\n", n_in, n_in > 0 ? in_sizes[0] : -1, out_size, ws_size, (size_t)WS_END); grid = -1; return; }
        int dev = 0, cus = 0, per_cu = 0;
        if (hipGetDevice(&dev) != hipSuccess || hipDeviceGetAttribute(&cus, hipDeviceAttributeMultiprocessorCount, dev) != hipSuccess) { grid = -1; return; }
        if (hipFuncSetAttribute((const void*)fwd_kernel, hipFuncAttributeMaxDynamicSharedMemorySize, LDS_BYTES) != hipSuccess) { fprintf(stderr, "kernel_launch: hipFuncSetAttribute failed\n"); grid = -1; return; }
        if (hipOccupancyMaxActiveBlocksPerMultiprocessor(&per_cu, (const void*)fwd_kernel, NWAVES * 64, LDS_BYTES) != hipSuccess || per_cu < 1) fprintf(stderr, "kernel_launch: occupancy query says %d\n", per_cu);
        (void)hipGetLastError();
        grid = cus;
    }
    if (grid < 0) return;
    if (hipMemsetAsync((char*)d_ws + WS_CTL, 0, CTL_ZERO_BYTES, stream) != hipSuccess) return;
    Args a{};
    for (int i = 0; i < 23; ++i) a.in[i] = (const float*)d_in[i];
    a.out = (float*)d_out; a.ws = (unsigned char*)d_ws; a.pad = 0;
#if MK_ONE_LAUNCH
    a.lo = 0; a.hi = N_STAGES; a.use_bar = 1;
    hipLaunchKernelGGL(fwd_kernel, dim3(grid), dim3(NWAVES * 64), LDS_BYTES, stream, a);
#else
    for (int s = 0; s < N_STAGES; ++s) { a.lo = s; a.hi = s + 1; a.use_bar = 0; hipLaunchKernelGGL(fwd_kernel, dim3(grid), dim3(NWAVES * 64), LDS_BYTES, stream, a); }
#endif
}
```

```cpp
#include <hip/hip_runtime.h>
#include <cstdio>
#include <cstdint>
namespace pg8 {
#define PG8_LAS __attribute__((address_space(3)))
typedef unsigned short bf16_t;
typedef short bf16x8 __attribute__((ext_vector_type(8)));
typedef float f32x4 __attribute__((ext_vector_type(4)));
typedef unsigned u32x4 __attribute__((ext_vector_type(4)));
constexpr int BM = 256, BK = 64, HALF = 128, HTB = HALF * BK * 2  , STAGE_BYTES = 8 * HTB, NXCD = 8, WGM = 4;

__host__ __device__ __forceinline__ int lds_byte(int r, int c) { const int st = (r >> 4) * 2 + (c >> 5), rr = r & 15, cc = c & 31, ob = rr * 64 + cc * 2; return st * 1024 + (ob ^ (((ob >> 9) & 1) << 5)); }
__host__ __device__ __forceinline__ void stage_rc(int b, int& R, int& C) { const int st = b / 1024, sb = b % 1024, swz = sb ^ (((sb >> 9) & 1) << 5); R = (st >> 1) * 16 + swz / 64; C = (st & 1) * 32 + (swz % 64) / 2; }
__host__ __device__ __forceinline__ int perm32(int rho) { const int n = rho >> 4, i = rho & 15; return 8 * (i >> 2) + 4 * n + (i & 3); }

struct Unit { int pm, pn; };
struct Gemm { const bf16_t* A; const bf16_t* Bt; int M, N, K; };

struct StaticOrder {
    int nM, nN, nwg, G, c, wgm;
    __host__ __device__ void init(int M, int N, int G_, int c_, int wgm_ = WGM) { nM = M / BM; nN = N / BM; nwg = nM * nN; G = G_; c = c_; wgm = wgm_; }
    __host__ __device__ bool next(int i, Unit& u) const {
        const long L = (long)i * G + c; if (L >= nwg) return false;
        int wgid = (int)L; { const int q = nwg / NXCD, r = nwg % NXCD, xcd = wgid % NXCD, off = wgid / NXCD; wgid = (xcd < r ? xcd * (q + 1) : r * (q + 1) + (xcd - r) * q) + off; }
        const int nig = wgm * nN, gid = wgid / nig, fm = gid * wgm, gsz = (nM - fm) < wgm ? (nM - fm) : wgm;
        u.pm = fm + ((wgid % nig) % gsz); u.pn = (wgid % nig) / gsz; return true;
    }
    __device__ __forceinline__ void a_ready(const Unit&) const {}
    __device__ __forceinline__ void done(const Unit&) const {}
};

__device__ __forceinline__ unsigned cvt_pk_bf16(float lo, float hi) { unsigned r; asm volatile("v_cvt_pk_bf16_f32 %0, %1, %2" : "=v"(r) : "v"(lo), "v"(hi)); return r; }
typedef float f32x2 __attribute__((ext_vector_type(2)));
__device__ __forceinline__ float sigmoid_f(float a) { return __builtin_amdgcn_rcpf(1.0f + __builtin_amdgcn_exp2f(-1.4426950408889634f * a)); }
__device__ __forceinline__ float bf_lo(unsigned w) { return __uint_as_float(w << 16); }
__device__ __forceinline__ float bf_hi(unsigned w) { return __uint_as_float(w & 0xffff0000u); }
typedef float f32x2e __attribute__((ext_vector_type(2)));
template <int MODE> struct EpiPair {
    static constexpr bool PERM = true, AFTER_DRAIN = false;
    bf16_t* O; int ldo;
    __device__ __forceinline__ void operator()(f32x4 (&acc)[2][2][4][2], const Unit& u, int wr, int wc, int fr, int fq) const {
        const int row0 = u.pm * BM + wr * 64 + fr, col0 = u.pn * HALF + wc * 32 + 8 * fq;
#pragma unroll
        for (int ai = 0; ai < 2; ++ai)
#pragma unroll
            for (int m = 0; m < 4; ++m) { bf16_t* rowp = O + (size_t)(row0 + ai * HALF + m * 16) * ldo + col0;
                float r[8];
#pragma unroll
                for (int n = 0; n < 2; ++n) { const f32x4 av = acc[ai][0][m][n], bv = acc[ai][1][m][n];
#pragma unroll
                    for (int i = 0; i < 4; ++i) { const float a = av[i], b = bv[i];
                        r[n * 4 + i] = (MODE == 0) ? a * sigmoid_f(a) * b : a * sigmoid_f(b); } }
                u32x4 w; w.x = cvt_pk_bf16(r[0], r[1]); w.y = cvt_pk_bf16(r[2], r[3]); w.z = cvt_pk_bf16(r[4], r[5]); w.w = cvt_pk_bf16(r[6], r[7]);
                *(u32x4*)rowp = w;
                if (m & 1) __builtin_amdgcn_sched_barrier(0); }
    }
};
struct EpiH {
    static constexpr bool PERM = true, AFTER_DRAIN = false;
    bf16_t* O; int ldo; int gate_tile0; bf16_t* gt; bf16_t* vts; bf16_t* vtd; bf16_t* vta;
    __device__ __forceinline__ void store_vt(f32x4 (&acc)[2][2][4][2], const Unit& u, int wr, int wc, int fr, int fq) const {
        bf16_t* vb; int nh, h0, lay = 0;
        if (u.pn < 6) { vb = vts; nh = 8; h0 = (u.pn - 4) * 4; } else if (u.pn < 15) { vb = vtd; nh = 12; h0 = (u.pn - 12) * 4; lay = u.pn - 12; } else { vb = vta; nh = 8; h0 = (u.pn - 21) * 4; }
        const int r0 = u.pm * BM + wr * 64 + fr, bl = r0 >> 11, t0 = r0 & 2047;
        const int pos0 = lay == 0 ? t0 : (lay == 1 ? (t0 & 3) * 512 + (t0 >> 2) : (t0 & 15) * 128 + (t0 >> 4));
        const int step_m = lay == 0 ? 16 : (lay == 1 ? 4 : 1), step_ai = 8 * step_m;
        bf16_t* p0 = vb + ((size_t)(bl * nh + h0 + (wc >> 1)) * 64 + 32 * (wc & 1) + 8 * fq) * 2048 + pos0;
#pragma unroll
        for (int ai = 0; ai < 2; ++ai)
#pragma unroll
            for (int m = 0; m < 4; ++m)
#pragma unroll
                for (int bj = 0; bj < 2; ++bj) { bf16_t* p = p0 + (size_t)bj * (2 * 64 * 2048) + ai * step_ai + m * step_m;
#pragma unroll
                    for (int n = 0; n < 2; ++n)
#pragma unroll
                        for (int i = 0; i < 4; i += 2) { const unsigned w = cvt_pk_bf16(acc[ai][bj][m][n][i], acc[ai][bj][m][n][i + 1]);
                            p[(size_t)(4 * n + i) * 2048] = (bf16_t)(w & 0xffffu); p[(size_t)(4 * n + i + 1) * 2048] = (bf16_t)(w >> 16); } }
    }
    __device__ __forceinline__ void operator()(f32x4 (&acc)[2][2][4][2], const Unit& u, int wr, int wc, int fr_in, int fq) const {
        int fr = fr_in; asm volatile("" : "+v"(fr));
        if (u.pn == 4 || u.pn == 5 || (u.pn >= 12 && u.pn <= 14) || u.pn == 21 || u.pn == 22) { store_vt(acc, u, wr, wc, fr, fq); return; }
        const int row0 = u.pm * BM + wr * 64 + fr, col0 = u.pn * BM + wc * 32 + 8 * fq; const bool sg = u.pn >= gate_tile0;
#pragma unroll
        for (int ai = 0; ai < 2; ++ai)
#pragma unroll
            for (int m = 0; m < 4; ++m) { bf16_t* rowp = O + (size_t)(row0 + ai * HALF + m * 16) * ldo + col0;
                if (sg) { const int gp = u.pn - gate_tile0;
                    rowp = gt + ((size_t)(u.pm * 4 + (gp >> 3)) * 8 + (gp & 7)) * 65536 + (size_t)(wr * 64 + fr + ai * HALF + m * 16) * 256 + wc * 32 + 8 * fq; }
#pragma unroll
                for (int bj = 0; bj < 2; ++bj) { f32x4 v0 = acc[ai][bj][m][0], v1 = acc[ai][bj][m][1];
                    if (sg) {
#pragma unroll
                        for (int i = 0; i < 4; ++i) { v0[i] = sigmoid_f(v0[i]); v1[i] = sigmoid_f(v1[i]); } }
                    u32x4 w; w.x = cvt_pk_bf16(v0[0], v0[1]); w.y = cvt_pk_bf16(v0[2], v0[3]); w.z = cvt_pk_bf16(v1[0], v1[1]); w.w = cvt_pk_bf16(v1[2], v1[3]);
                    *(u32x4*)(rowp + bj * HALF) = w; }
                if (m & 1) __builtin_amdgcn_sched_barrier(0); }
    }
};
struct EpiResid {
    static constexpr bool PERM = false, AFTER_DRAIN = false;
    const float* base; float* out; const f32x2e* stat; const float* g; const float* b; int ldc, nrm; float alpha, sc;
    __device__ __forceinline__ void operator()(f32x4 (&acc)[2][2][4][2], const Unit& u, int wr, int wc, int fr, int fq) const {
        const int col0 = u.pn * BM + wc * 32 + 4 * fq, row0 = u.pm * BM + wr * 64 + fr;
        f32x4 gg[2][2], bb[2][2];
#pragma unroll
        for (int bj = 0; bj < 2; ++bj)
#pragma unroll
            for (int n = 0; n < 2; ++n) { gg[bj][n] = (f32x4){1.f, 1.f, 1.f, 1.f}; bb[bj][n] = (f32x4){0.f, 0.f, 0.f, 0.f};
                if (nrm) { gg[bj][n] = *(const f32x4*)(g + col0 + bj * HALF + n * 16); bb[bj][n] = *(const f32x4*)(b + col0 + bj * HALF + n * 16); } }
        f32x2e stq[2]; stq[0] = nrm ? stat[row0] : (f32x2e){0.f, 1.f};
        f32x4 yq[2][2][2];
#pragma unroll
        for (int bj = 0; bj < 2; ++bj)
#pragma unroll
            for (int n = 0; n < 2; ++n) yq[0][bj][n] = *(const f32x4*)(base + (size_t)row0 * ldc + col0 + bj * HALF + n * 16);
#pragma unroll
        for (int k = 0; k < 8; ++k) { const int ai = k >> 2, m = k & 3; const int row = row0 + ai * HALF + m * 16; const size_t off = (size_t)row * ldc + col0;
            if (k < 7) { const int rn = row0 + ((k + 1) >> 2) * HALF + ((k + 1) & 3) * 16; stq[(k + 1) & 1] = nrm ? stat[rn] : (f32x2e){0.f, 1.f};
#pragma unroll
                for (int bj = 0; bj < 2; ++bj)
#pragma unroll
                    for (int n = 0; n < 2; ++n) yq[(k + 1) & 1][bj][n] = *(const f32x4*)(base + (size_t)rn * ldc + col0 + bj * HALF + n * 16); }
            const f32x2e st = stq[k & 1];
#pragma unroll
            for (int bj = 0; bj < 2; ++bj)
#pragma unroll
                for (int n = 0; n < 2; ++n) { const size_t o2 = off + bj * HALF + n * 16;
                    const f32x4 xp = (yq[k & 1][bj][n] - st.x) * st.y * gg[bj][n] + bb[bj][n];
                    const f32x4 y = xp * alpha + acc[ai][bj][m][n] * sc;
                    *(f32x4*)(out + o2) = y; }
            __builtin_amdgcn_sched_barrier(0); }
    }
};
struct EpiGateAcc {
    static constexpr bool PERM = true, AFTER_DRAIN = false;
    const bf16_t* G; int branch; bf16_t* O; int ldo; int first;
    __device__ __forceinline__ void operator()(f32x4 (&acc)[2][2][4][2], const Unit& u, int wr, int wc, int fr, int fq) const {
        const int row0 = u.pm * BM + wr * 64 + fr, col0 = u.pn * BM + wc * 32 + 8 * fq;
#pragma unroll
        for (int ai = 0; ai < 2; ++ai) {
            u32x4 gw[4][2], pw[4][2];
#pragma unroll
            for (int m = 0; m < 4; ++m)
#pragma unroll
                for (int bj = 0; bj < 2; ++bj) { const int row = row0 + ai * HALF + m * 16;
                    gw[m][bj] = *(const u32x4*)(G + ((size_t)(u.pm * 4 + branch) * 8 + u.pn) * 65536 + (size_t)(row - u.pm * BM) * 256 + wc * 32 + 8 * fq + bj * HALF);
                    pw[m][bj] = (u32x4){0u, 0u, 0u, 0u}; if (!first) pw[m][bj] = *(const u32x4*)(O + (size_t)row * ldo + col0 + bj * HALF); }
#pragma unroll
            for (int m = 0; m < 4; ++m)
#pragma unroll
                for (int bj = 0; bj < 2; ++bj) { const int row = row0 + ai * HALF + m * 16; bf16_t* op = O + (size_t)row * ldo + col0 + bj * HALF;
                    const f32x4 v0 = acc[ai][bj][m][0], v1 = acc[ai][bj][m][1]; const u32x4 g = gw[m][bj], p = pw[m][bj];
                    u32x4 w;
                    w.x = cvt_pk_bf16(bf_lo(p.x) + bf_lo(g.x) * v0[0], bf_hi(p.x) + bf_hi(g.x) * v0[1]);
                    w.y = cvt_pk_bf16(bf_lo(p.y) + bf_lo(g.y) * v0[2], bf_hi(p.y) + bf_hi(g.y) * v0[3]);
                    w.z = cvt_pk_bf16(bf_lo(p.z) + bf_lo(g.z) * v1[0], bf_hi(p.z) + bf_hi(g.z) * v1[1]);
                    w.w = cvt_pk_bf16(bf_lo(p.w) + bf_lo(g.w) * v1[2], bf_hi(p.w) + bf_hi(g.w) * v1[3]);
                    *(u32x4*)op = w; }
        }
    }
};
template <class Epi, class Sched, bool ALIGN_EPI = false, bool SP2 = false>
__device__ __forceinline__ void gemm_phase(PG8_LAS unsigned char* lds, const Gemm g, const Sched& S, const Epi& E, int tid_in) {
    int tid_ = tid_in; asm volatile("" : "+v"(tid_));
    const int tid = tid_, wid = __builtin_amdgcn_readfirstlane(tid >> 6), lane = tid & 63, wr = wid >> 2, wc = wid & 3, fr = lane & 15, fq = lane >> 4;
    const int K = g.K, nt = K / BK;
    unsigned voffA[2], voffB[2];
#pragma unroll
    for (int i = 0; i < 2; ++i) { int R, C; stage_rc(tid * 16 + i * 8192, R, C); const int Rb = Epi::PERM ? ((R & ~31) + perm32(R & 31)) : R;
        voffA[i] = (unsigned)(R * K + C) * 2u; voffB[i] = (unsigned)(Rb * K + C) * 2u; }
    const size_t kstep = (size_t)(BK * 2);
    const size_t hstep = (size_t)HALF * K * 2;
    const size_t tstep = 2 * hstep;
    const unsigned ldsw = (unsigned)wid * 1024u;
    const int aoff = lds_byte(wr * 64 + fr, fq * 8), boff = lds_byte(wc * 32 + fr, fq * 8);
#define PG8_SA(b, h) (((b) * 2 + (h)) * HTB)
#define PG8_SB(b, h) ((4 + (b) * 2 + (h)) * HTB)
#define PG8_STAGE(bufoff, gbase, voff) do { _Pragma("unroll") for (int _i = 0; _i < 2; ++_i) \
        __builtin_amdgcn_global_load_lds((const unsigned*)((const char*)(gbase) + (voff)[_i]), (PG8_LAS unsigned*)(lds + (bufoff) + ldsw + _i * 8192), 16, 0, 0); } while (0)
#define PG8_LDA(dst, b, h) do { _Pragma("unroll") for (int m = 0; m < 4; ++m) _Pragma("unroll") for (int k = 0; k < 2; ++k) dst[m][k] = *(const PG8_LAS bf16x8*)(lds + PG8_SA(b, h) + aoff + m * 2048 + k * 1024); } while (0)
#define PG8_LDB(dst, b, h) do { _Pragma("unroll") for (int n = 0; n < 2; ++n) _Pragma("unroll") for (int k = 0; k < 2; ++k) dst[n][k] = *(const PG8_LAS bf16x8*)(lds + PG8_SB(b, h) + boff + n * 2048 + k * 1024); } while (0)
#define PG8_MMA(ai, bj, At, Bt) do { __builtin_amdgcn_s_setprio(1); _Pragma("unroll") for (int m = 0; m < 4; ++m) _Pragma("unroll") for (int n = 0; n < 2; ++n) _Pragma("unroll") for (int k = 0; k < 2; ++k) \
        acc[ai][bj][m][n] = __builtin_amdgcn_mfma_f32_16x16x32_bf16(Bt[n][k], At[m][k], acc[ai][bj][m][n], 0, 0, 0); __builtin_amdgcn_s_setprio(0); } while (0)
#define PG8_WAIT_V(n) asm volatile("s_waitcnt vmcnt(" #n ")" ::: "memory")
#define PG8_WAIT_L(n) asm volatile("s_waitcnt lgkmcnt(" #n ")" ::: "memory")
#define PG8_BAR __builtin_amdgcn_s_barrier()
#define PG8_SCHED __builtin_amdgcn_sched_barrier(0)
    Unit cur, nxt; int ui = 0;
    if (!S.next(0, cur)) return;
    f32x4 acc[2][2][4][2];
#pragma unroll
    for (int a = 0; a < 2; ++a)
#pragma unroll
        for (int b = 0; b < 2; ++b)
#pragma unroll
            for (int m = 0; m < 4; ++m)
#pragma unroll
                for (int n = 0; n < 2; ++n) acc[a][b][m][n] = (f32x4){0.f, 0.f, 0.f, 0.f};
    bf16x8 At[4][2], B0[2][2], B1[2][2];
    const char* cA = (const char*)g.A + (size_t)cur.pm * tstep; const char* cB = (const char*)g.Bt + (size_t)cur.pn * tstep;
    S.a_ready(cur);
    if constexpr (SP2) {
        PG8_STAGE(PG8_SB(0, 0), cB, voffB); PG8_STAGE(PG8_SB(0, 1), cB + hstep, voffB); PG8_STAGE(PG8_SA(0, 0), cA, voffA); PG8_STAGE(PG8_SA(0, 1), cA + hstep, voffA);
        if (wr == 1) PG8_BAR;
        PG8_WAIT_V(2); PG8_BAR;
        PG8_STAGE(PG8_SB(1, 0), cB + kstep, voffB); PG8_STAGE(PG8_SA(1, 0), cA + kstep, voffA); PG8_STAGE(PG8_SB(1, 1), cB + hstep + kstep, voffB);
        PG8_WAIT_V(6); PG8_BAR;
    } else {
        PG8_STAGE(PG8_SB(0, 0), cB, voffB); PG8_STAGE(PG8_SA(0, 0), cA, voffA); PG8_STAGE(PG8_SB(0, 1), cB + hstep, voffB); PG8_STAGE(PG8_SA(0, 1), cA + hstep, voffA);
        if (wr == 1) PG8_BAR;
        PG8_WAIT_V(4); PG8_BAR;
        PG8_STAGE(PG8_SB(1, 0), cB + kstep, voffB); PG8_STAGE(PG8_SA(1, 0), cA + kstep, voffA); PG8_STAGE(PG8_SB(1, 1), cB + hstep + kstep, voffB);
        PG8_WAIT_V(6); PG8_BAR;
    }
    for (;;) {
        const bool has_next = S.next(ui + 1, nxt);
        const char* nA = has_next ? (const char*)g.A + (size_t)nxt.pm * tstep : cA; const char* nB = has_next ? (const char*)g.Bt + (size_t)nxt.pn * tstep : cB;
        for (int t = 0; t < nt; t += 2) {
            const bool last = (t == nt - 2);
            const char* a1 = cA + (size_t)(t + 1) * kstep;
            const char* a2 = last ? nA : cA + (size_t)(t + 2) * kstep; const char* b2 = last ? nB : cB + (size_t)(t + 2) * kstep;
            const char* a3 = a2 + kstep; const char* b3 = b2 + kstep;
            if (last && has_next) S.a_ready(nxt);
            if constexpr (SP2) {
            PG8_LDB(B0, 0, 0); PG8_LDB(B1, 0, 1); PG8_SCHED; PG8_LDA(At, 0, 0); PG8_STAGE(PG8_SA(1, 1), a1 + hstep, voffA);
            PG8_WAIT_V(8); PG8_WAIT_L(0); PG8_BAR; PG8_MMA(0, 0, At, B0); PG8_MMA(0, 1, At, B1); PG8_BAR; PG8_SCHED;
            PG8_LDA(At, 0, 1); PG8_STAGE(PG8_SB(0, 0), b2, voffB); PG8_STAGE(PG8_SB(0, 1), b2 + hstep, voffB); PG8_STAGE(PG8_SA(0, 0), a2, voffA);
            PG8_WAIT_V(8); PG8_WAIT_L(0); PG8_BAR; PG8_MMA(1, 0, At, B0); PG8_MMA(1, 1, At, B1); PG8_BAR; PG8_SCHED;
            PG8_LDB(B0, 1, 0); PG8_LDB(B1, 1, 1); PG8_SCHED; PG8_LDA(At, 1, 0); PG8_STAGE(PG8_SA(0, 1), a2 + hstep, voffA);
            PG8_WAIT_V(8); PG8_WAIT_L(0); PG8_BAR; PG8_MMA(0, 0, At, B0); PG8_MMA(0, 1, At, B1); PG8_BAR; PG8_SCHED;
            PG8_LDA(At, 1, 1); PG8_STAGE(PG8_SB(1, 0), b3, voffB); PG8_STAGE(PG8_SB(1, 1), b3 + hstep, voffB); PG8_STAGE(PG8_SA(1, 0), a3, voffA);
            PG8_WAIT_V(8); PG8_WAIT_L(0); PG8_BAR; PG8_MMA(1, 0, At, B0); PG8_MMA(1, 1, At, B1); PG8_BAR; PG8_SCHED;
            } else {
            PG8_LDB(B0, 0, 0); PG8_SCHED; PG8_LDA(At, 0, 0); PG8_STAGE(PG8_SA(1, 1), a1 + hstep, voffA);
            PG8_WAIT_L(8); PG8_BAR; PG8_WAIT_L(0); PG8_MMA(0, 0, At, B0); PG8_BAR; PG8_SCHED;
            PG8_LDB(B1, 0, 1); PG8_STAGE(PG8_SB(0, 0), b2, voffB);
            PG8_BAR; PG8_WAIT_L(0); PG8_MMA(0, 1, At, B1); PG8_BAR;
            PG8_LDA(At, 0, 1); PG8_STAGE(PG8_SA(0, 0), a2, voffA);
            PG8_BAR; PG8_WAIT_L(0); PG8_MMA(1, 0, At, B0); PG8_BAR; PG8_SCHED;
            PG8_STAGE(PG8_SB(0, 1), b2 + hstep, voffB);
            PG8_WAIT_V(6); PG8_BAR; PG8_MMA(1, 1, At, B1); PG8_BAR;
            PG8_LDB(B0, 1, 0); PG8_SCHED; PG8_LDA(At, 1, 0); PG8_STAGE(PG8_SA(0, 1), a2 + hstep, voffA);
            PG8_WAIT_L(8); PG8_BAR; PG8_WAIT_L(0); PG8_MMA(0, 0, At, B0); PG8_BAR; PG8_SCHED;
            PG8_LDB(B1, 1, 1); PG8_STAGE(PG8_SB(1, 0), b3, voffB);
            PG8_BAR; PG8_WAIT_L(0); PG8_MMA(0, 1, At, B1); PG8_BAR;
            PG8_LDA(At, 1, 1); PG8_STAGE(PG8_SA(1, 0), a3, voffA);
            PG8_BAR; PG8_WAIT_L(0); PG8_MMA(1, 0, At, B0); PG8_BAR; PG8_SCHED;
            PG8_STAGE(PG8_SB(1, 1), b3 + hstep, voffB);
            PG8_WAIT_V(6); PG8_BAR; PG8_MMA(1, 1, At, B1); PG8_BAR;
            }
        }
        if constexpr (ALIGN_EPI) { if (wr == 0) PG8_BAR; }
        if constexpr (!Epi::AFTER_DRAIN) { E(acc, cur, wr, wc, fr, fq); S.done(cur); }
        if (!has_next) break;
#pragma unroll
        for (int a = 0; a < 2; ++a)
#pragma unroll
            for (int b = 0; b < 2; ++b)
#pragma unroll
                for (int m = 0; m < 4; ++m)
#pragma unroll
                    for (int n = 0; n < 2; ++n) acc[a][b][m][n] = (f32x4){0.f, 0.f, 0.f, 0.f};
        cur = nxt; cA = nA; cB = nB; ++ui;
        if constexpr (ALIGN_EPI) { if (wr == 1) PG8_BAR; }
    }
    PG8_WAIT_V(0);
    if constexpr (!ALIGN_EPI) { if (wr == 0) PG8_BAR; }
    PG8_BAR;
    if constexpr (Epi::AFTER_DRAIN) { E.fused(acc, cur, wr, wc, fr, fq, lds, wid, lane); S.done(cur); }
#undef PG8_SA
#undef PG8_SB
#undef PG8_STAGE
#undef PG8_LDA
#undef PG8_LDB
#undef PG8_MMA
#undef PG8_WAIT_V
#undef PG8_WAIT_L
#undef PG8_BAR
#undef PG8_SCHED
}
}
#ifndef MK_PROBE
#define MK_PROBE 0
#define PROBE_KIND 1
#define PROBE_SEL 0
#define PROBE_AMP 4
#define PROBE_LO 0
#define PROBE_HI 256
#define PROBE_REGION 23
#endif

constexpr int NWAVES = 8;
#ifndef WGM_UP
#define WGM_UP 8
#endif
#ifndef MK_ONE_LAUNCH
#define MK_ONE_LAUNCH 1
#endif
constexpr int BATCH = 16, SEQ = 2048, D = 2048, M = BATCH * SEQ, DFF = 5632, NUP = 2 * DFF, DEPTH = 2;
constexpr int INC = 14664, NH = 14848, HP = 6656, GATE_T0 = 26;
constexpr int NCH = 2, MC = M / NCH, BC = BATCH / NCH;
constexpr int C_SBQ = 0, C_SBK = 512, C_SBV = 1024, C_DQ = 1536, C_DK = 2304, C_DV = 3072, C_U = 3840, C_AQ = 4352, C_AK = 4864, C_AV = 5376, C_IQ = 5888, C_IK = 6400, C_IW = 6464, C_GATE = 6656;
constexpr float LOG2E = 1.4426950408889634f, QSC = 0.125f * 1.4426950408889634f, DN_ALPHA = 1.4142135623730951f, LN_EPS = 1e-5f;
constexpr size_t MiB = 1u << 20;
constexpr size_t WS_CTL = 0, CTL_ZERO_BYTES = 1 * MiB;
constexpr size_t WS_WT = 1 * MiB;
constexpr size_t W_1U = 0, W_1D = W_1U + (size_t)NUP * D, W_IN = W_1D + (size_t)D * DFF, W_GLU = W_IN + (size_t)NH * D, W_SB = W_GLU + 1024 * 512, W_DIL = W_SB + 2048 * 512,
                 W_SSM = W_DIL + 2048 * 256, W_DSA = W_SSM + 2048 * 512, W_OUT = W_DSA + 2048 * 512, W_2U = W_OUT + (size_t)D * D, W_2D = W_2U + (size_t)NUP * D, W_END = W_2D + (size_t)D * DFF;
static_assert(W_END * 2 <= 207 * MiB, "weights region");
constexpr size_t WS_XB = 208 * MiB;
constexpr size_t WS_MG = 336 * MiB;
constexpr size_t WS_H = 464 * MiB, WS_GT = WS_H + 208 * MiB;
constexpr size_t WS_YSB = 928 * MiB, WS_YDIL = 944 * MiB, WS_YSSM = 952 * MiB, WS_YDSA = 968 * MiB, WS_YG = 984 * MiB, WS_MASK = 1000 * MiB, WS_VTS = 1004 * MiB, WS_VTD = 1020 * MiB, WS_VTA = 1044 * MiB, WS_SSMT = 1060 * MiB, WS_END = 1070 * MiB;
static_assert((size_t)MC * HP * 2 <= 208 * MiB && (size_t)(MC / 256) * 32 * 65536 * 2 <= 256 * MiB && (size_t)M * DFF * 2 <= 464 * MiB, "h region");
constexpr size_t WS_STAT = WS_CTL + 512 * 1024;
constexpr int CW_BAR = 4096;
constexpr int RING_OFF = 0, RING_BYTES = 131072, LDSCTL_OFF = RING_BYTES, MISC_OFF = LDSCTL_OFF + 320, LDS_BYTES = 147456;

#define GAS __attribute__((address_space(1)))
#define LAS __attribute__((address_space(3)))
typedef unsigned short bf16;
typedef unsigned v4u __attribute__((ext_vector_type(4)));
typedef float f32x4 __attribute__((ext_vector_type(4)));
typedef GAS unsigned gu32;
typedef float f32x2v_ __attribute__((ext_vector_type(2)));
#define RLX_AGENT __ATOMIC_RELAXED, __HIP_MEMORY_SCOPE_AGENT
#define LDS_WAIT() asm volatile("s_waitcnt lgkmcnt(0)" ::: "memory")
#define VM_WAIT() asm volatile("s_waitcnt vmcnt(0)" ::: "memory")
__device__ __forceinline__ unsigned f2bf(float f) { unsigned u = __builtin_bit_cast(unsigned, f); return (u + 0x7fffu + ((u >> 16) & 1u)) >> 16; }
__device__ __forceinline__ unsigned pk2(float lo, float hi) { return f2bf(lo) | (f2bf(hi) << 16); }
__device__ __forceinline__ float bflo(unsigned w) { return __uint_as_float(w << 16); }
__device__ __forceinline__ float bfhi(unsigned w) { return __uint_as_float(w & 0xffff0000u); }
__device__ __forceinline__ void ld8(const bf16* p, float* f) { const v4u w = *(const GAS v4u*)p; f[0] = bflo(w.x); f[1] = bfhi(w.x); f[2] = bflo(w.y); f[3] = bfhi(w.y); f[4] = bflo(w.z); f[5] = bfhi(w.z); f[6] = bflo(w.w); f[7] = bfhi(w.w); }
__device__ __forceinline__ void st8(bf16* p, const float* f) { v4u w; w.x = pk2(f[0], f[1]); w.y = pk2(f[2], f[3]); w.z = pk2(f[4], f[5]); w.w = pk2(f[6], f[7]); *(GAS v4u*)p = w; }
__device__ __forceinline__ float ex2(float x) { return __builtin_amdgcn_exp2f(x); }
__device__ __forceinline__ float lg2(float x) { return __builtin_amdgcn_logf(x); }
__device__ __forceinline__ float wave_sum(float v) {
#pragma unroll
    for (int o = 1; o < 64; o <<= 1) v += __shfl_xor(v, o);
    return v;
}
__device__ __forceinline__ int t5_bucket(int d) {
    if (d < 16) return d;
    return 15 + (d >= 16) + (d >= 19) + (d >= 21) + (d >= 24) + (d >= 27) + (d >= 31) + (d >= 35) + (d >= 40) + (d >= 46) + (d >= 52) + (d >= 59) + (d >= 67) + (d >= 77) + (d >= 87) + (d >= 99) + (d >= 113);
}

#define XB_TMO      128
#define XB_XCNT(j)  (256  + 64 * (j))
#define XB_XSUB(j)  (1280 + 64 * (j))
#define XB_XGEN(j)  (2304 + 64 * (j))
#define XB_TOP      3328
#define XB_TOPGEN   3392
#define XCD_BAR_WORDS 3456
#define XB_SPIN_CAP (1u << 18)

__device__ __forceinline__ unsigned xb_ld(unsigned* p)              { return __hip_atomic_load(p, __ATOMIC_RELAXED, __HIP_MEMORY_SCOPE_AGENT); }
__device__ __forceinline__ unsigned xb_add(unsigned* p, unsigned v) { return __hip_atomic_fetch_add(p, v, __ATOMIC_RELAXED, __HIP_MEMORY_SCOPE_AGENT); }
__device__ __forceinline__ unsigned xb_xcc_id() { return (unsigned)__builtin_amdgcn_s_getreg((3 << 11) | 20) & 0xFu; }
#define XB_SPIN(cond, bar) do { unsigned _sp = 0; while (cond) { __builtin_amdgcn_s_sleep(1); \
    if ((++_sp & 255u) == 0u) { if (xb_ld(&(bar)[XB_TMO])) break; if (_sp > XB_SPIN_CAP) { atomicAdd(&(bar)[XB_TMO], 1u); break; } } } } while (0)

struct XcdBarrier {
    unsigned* bar; unsigned x;
    volatile LAS unsigned* st;
};

__device__ __forceinline__ XcdBarrier xcd_barrier_post(unsigned* bar, volatile LAS unsigned* st) {
    XcdBarrier b; b.bar = bar; b.x = xb_xcc_id(); b.st = st;
    if (threadIdx.x == 0) (void)xb_add(&bar[XB_XCNT(b.x)], 1u);
    return b;
}
__device__ __forceinline__ void xcd_barrier_complete(unsigned* bar, unsigned x, unsigned& nloc, unsigned& nx) {
    const unsigned G = gridDim.x * gridDim.y * gridDim.z;
    unsigned sum, cnt, mine, sp = 0u;
    for (;;) {
        sum = 0u; cnt = 0u; mine = 0u;
#pragma unroll
        for (unsigned j = 0; j < 16; ++j) { const unsigned c = xb_ld(&bar[XB_XCNT(j)]); sum += c; cnt += (c > 0u) ? 1u : 0u; mine = (j == x) ? c : mine; }
        if (sum == G) break;
        __builtin_amdgcn_s_sleep(1);
        if ((++sp & 255u) == 0u) { if (xb_ld(&bar[XB_TMO])) break; if (sp > XB_SPIN_CAP) { atomicAdd(&bar[XB_TMO], 1u); break; } }
    }
    nloc = mine > 0u ? mine : 1u; nx = cnt > 0u ? cnt : 1u;
}

__device__ __forceinline__ void xcd_barrier(const XcdBarrier& b) {
    asm volatile("s_waitcnt vmcnt(0)" ::: "memory");
    __syncthreads();
    if (threadIdx.x == 0) {
        unsigned* bar = b.bar;
        __builtin_amdgcn_s_waitcnt(0);
        unsigned nloc = b.st[0], nx = b.st[1];
        if (nloc == 0u) { xcd_barrier_complete(bar, b.x, nloc, nx); b.st[0] = nloc; b.st[1] = nx; }
        const unsigned old = xb_add(&bar[XB_XSUB(b.x)], 1u);
        const unsigned gen = old / nloc;
        if (old + 1u == (gen + 1u) * nloc) {
            __builtin_amdgcn_fence(__ATOMIC_RELEASE, "agent");
            asm volatile("s_waitcnt vmcnt(0)" ::: "memory");
            const unsigned og = xb_add(&bar[XB_TOP], 1u);
            const unsigned tg = og / nx;
            if (og + 1u == (tg + 1u) * nx) xb_add(&bar[XB_TOPGEN], 1u);
            else XB_SPIN(xb_ld(&bar[XB_TOPGEN]) == tg, bar);
            __builtin_amdgcn_fence(__ATOMIC_ACQUIRE, "agent");
            xb_add(&bar[XB_XGEN(b.x)], 1u);
            asm volatile("s_waitcnt vmcnt(0)" ::: "memory");
        } else {
            XB_SPIN(xb_ld(&bar[XB_XGEN(b.x)]) == gen, bar);
            __builtin_amdgcn_fence(__ATOMIC_ACQUIRE, "agent");
            asm volatile("s_waitcnt vmcnt(0)" ::: "memory");
        }
    }
    __syncthreads();
}


struct Frame {
    LAS unsigned char* lds;
    int tid, lane, wave, G;
};

struct MapId { __device__ __forceinline__ void operator()(int np, int& src, float& sc) const { src = np; sc = 1.f; } };
struct MapPair { int half; __device__ __forceinline__ void operator()(int np, int& src, float& sc) const { const int pn = np >> 8, bj = (np >> 7) & 1, c = np & 127; src = bj * half + 128 * pn + c; sc = 1.f; } };
struct MapIn { __device__ __forceinline__ void operator()(int np, int& src, float& sc) const {
    if (np < 6472) { src = np; sc = (np < 512 || (np >= 1536 && np < 2304) || (np >= 4352 && np < 4864)) ? QSC : 1.f; }
    else if (np < C_GATE) { src = -1; sc = 0.f; }
    else { src = np - (C_GATE - 6472); sc = 1.f; } } };
template <class Map>
__device__ __forceinline__ void tr_item(const float* W, int K, int N, int nblk, bf16* WT, LAS float* scr, int item, int lane, const Map& map) {
    const int kb = item / nblk, nb = item % nblk, k0 = 64 * kb, n0 = 32 * nb;
    int src; float sc; map(n0 + 4 * (lane & 7), src, sc);
    const GAS float* col = (const GAS float*)W + (src < 0 ? 0 : src);
#pragma unroll
    for (int i = 0; i < 8; ++i) { const int kk = 8 * i + (lane >> 3); f32x4 v = *(const GAS f32x4*)(col + (size_t)(k0 + kk) * N); if (src < 0) v = (f32x4){0.f, 0.f, 0.f, 0.f}; v = v * sc;
        LAS float* d = scr + kk * 33 + 4 * (lane & 7); d[0] = v.x; d[1] = v.y; d[2] = v.z; d[3] = v.w; }
    LDS_WAIT(); asm volatile("" ::: "memory");
    const int c = lane & 7;
#pragma unroll
    for (int j = 0; j < 4; ++j) { const int n = (lane >> 3) + 8 * j; const LAS float* s = scr + (8 * c) * 33 + n;
        v4u o; o.x = pk2(s[0 * 33], s[1 * 33]); o.y = pk2(s[2 * 33], s[3 * 33]); o.z = pk2(s[4 * 33], s[5 * 33]); o.w = pk2(s[6 * 33], s[7 * 33]);
        *(GAS v4u*)(WT + (size_t)(n0 + n) * K + k0 + 8 * c) = o; }
    LDS_WAIT(); asm volatile("" ::: "memory");
}
struct WPtrs { const float *up1, *dn1, *win, *glu, *sb, *dil, *ssm, *dsa, *wout, *up2, *dn2; };
__device__ __forceinline__ void weights_phase(const Frame& F, const WPtrs& P, bf16* WT) {
    LAS float* scr = (LAS float*)(F.lds + RING_OFF + F.wave * 16384);
    int gw_ = blockIdx.x * NWAVES + F.wave; asm volatile("" : "+s"(gw_));
    const int gw = gw_, NGW = F.G * NWAVES;
    constexpr int I_UP = (D / 64) * (NUP / 32), I_IN = (D / 64) * (NH / 32), I_DN = (DFF / 64) * (D / 32), I_GLU = (512 / 64) * (1024 / 32), I_B5 = (512 / 64) * (D / 32), I_B2 = (256 / 64) * (D / 32), I_OUT = (D / 64) * (D / 32);
    constexpr int NITEMS = 2 * I_UP + I_IN + 2 * I_DN + I_GLU + 3 * I_B5 + I_B2 + I_OUT;
    for (int it = gw; it < NITEMS; it += NGW) {
        int r = it;
        if (r < I_UP) { tr_item(P.up1, D, NUP, NUP / 32, WT + W_1U, scr, r, F.lane, MapPair{DFF}); continue; } r -= I_UP;
        if (r < I_UP) { tr_item(P.up2, D, NUP, NUP / 32, WT + W_2U, scr, r, F.lane, MapPair{DFF}); continue; } r -= I_UP;
        if (r < I_IN) { tr_item(P.win, D, INC, NH / 32, WT + W_IN, scr, r, F.lane, MapIn{}); continue; } r -= I_IN;
        if (r < I_DN) { tr_item(P.dn1, DFF, D, D / 32, WT + W_1D, scr, r, F.lane, MapId{}); continue; } r -= I_DN;
        if (r < I_DN) { tr_item(P.dn2, DFF, D, D / 32, WT + W_2D, scr, r, F.lane, MapId{}); continue; } r -= I_DN;
        if (r < I_OUT) { tr_item(P.wout, D, D, D / 32, WT + W_OUT, scr, r, F.lane, MapId{}); continue; } r -= I_OUT;
        if (r < I_B5) { tr_item(P.sb, 512, D, D / 32, WT + W_SB, scr, r, F.lane, MapId{}); continue; } r -= I_B5;
        if (r < I_B5) { tr_item(P.ssm, 512, D, D / 32, WT + W_SSM, scr, r, F.lane, MapId{}); continue; } r -= I_B5;
        if (r < I_B5) { tr_item(P.dsa, 512, D, D / 32, WT + W_DSA, scr, r, F.lane, MapId{}); continue; } r -= I_B5;
        if (r < I_B2) { tr_item(P.dil, 256, D, D / 32, WT + W_DIL, scr, r, F.lane, MapId{}); continue; } r -= I_B2;
        tr_item(P.glu, 512, 1024, 1024 / 32, WT + W_GLU, scr, r, F.lane, MapPair{512});
    }
}
__device__ __forceinline__ void cast_phase(const Frame& F, const float* x, bf16* xb) {
    const size_t n8 = (size_t)M * D / 8, stride = (size_t)F.G * NWAVES * 64;
    for (size_t i = (size_t)blockIdx.x * NWAVES * 64 + F.tid; i < n8; i += stride) {
        const f32x4 a = ((const GAS f32x4*)x)[2 * i], b = ((const GAS f32x4*)x)[2 * i + 1];
        v4u w; w.x = pk2(a.x, a.y); w.y = pk2(a.z, a.w); w.z = pk2(b.x, b.y); w.w = pk2(b.z, b.w);
        ((GAS v4u*)xb)[i] = w; }
}
__device__ __forceinline__ void ln_phase(const Frame& F, float* y, const float* g, const float* b, bf16* xb, f32x2v_* stat, int write_x) {
    const int gw = blockIdx.x * NWAVES + F.wave, NGW = F.G * NWAVES;
    f32x4 vn[8];
    if (gw < M) { const GAS f32x4* x0 = (const GAS f32x4*)(y + (size_t)gw * D) + F.lane;
#pragma unroll
        for (int j = 0; j < 8; ++j) vn[j] = x0[64 * j]; }
    for (int m = gw; m < M; m += NGW) {
        GAS f32x4* xr = (GAS f32x4*)(y + (size_t)m * D) + F.lane;
        f32x4 v[8]; float s = 0.f;
#pragma unroll
        for (int j = 0; j < 8; ++j) { v[j] = vn[j]; s += (v[j].x + v[j].y) + (v[j].z + v[j].w); }
        { const int mn = (m + NGW < M) ? m + NGW : m; const GAS f32x4* xn = (const GAS f32x4*)(y + (size_t)mn * D) + F.lane;
#pragma unroll
          for (int j = 0; j < 8; ++j) vn[j] = xn[64 * j]; }
        const float mean = wave_sum(s) * (1.f / D); float s2 = 0.f;
#pragma unroll
        for (int j = 0; j < 8; ++j) { v[j] = v[j] - mean; s2 += (v[j].x * v[j].x + v[j].y * v[j].y) + (v[j].z * v[j].z + v[j].w * v[j].w); }
        const float rstd = 1.f / sqrtf(wave_sum(s2) * (1.f / D) + LN_EPS);
        if (F.lane == 0) stat[m] = (f32x2v_){mean, rstd};
        GAS unsigned long long* o8 = (GAS unsigned long long*)(xb + (size_t)m * D) + F.lane;
#pragma unroll
        for (int j = 0; j < 8; ++j) { const f32x4 gg = ((const GAS f32x4*)g)[F.lane + 64 * j], bb = ((const GAS f32x4*)b)[F.lane + 64 * j];
            const f32x4 o = v[j] * rstd * gg + bb; if (write_x) xr[64 * j] = o;
            o8[64 * j] = (unsigned long long)pk2(o.x, o.y) | ((unsigned long long)pk2(o.z, o.w) << 32); }
    }
}

struct SsmPtrs { const float *lam_re, *lam_im, *log_dt, *b_re, *b_im, *c_re, *c_im, *dsk; };
__device__ __forceinline__ unsigned fkey(float x) { const unsigned b = __float_as_uint(x); return b ^ ((b >> 31) ? 0xFFFFFFFFu : 0x80000000u); }
typedef short bf16x8v __attribute__((ext_vector_type(8)));
typedef float f32x16 __attribute__((ext_vector_type(16)));
typedef float f32x2t __attribute__((ext_vector_type(2))); typedef __bf16 bf16x2t __attribute__((ext_vector_type(2)));
__device__ __forceinline__ unsigned cvtpk(float lo, float hi) { f32x2t v = {lo, hi}; bf16x2t b = __builtin_convertvector(v, bf16x2t); return __builtin_bit_cast(unsigned, b); }
#define MFMA32(a, b, c) __builtin_amdgcn_mfma_f32_32x32x16_bf16((a), (b), (c), 0, 0, 0)
__device__ __forceinline__ int crow(int r, int hi) { return (r & 3) + 8 * (r >> 2) + 4 * hi; }
__device__ __forceinline__ int pi32(int r) { return (r & 0x13) | ((r & 4) << 1) | ((r & 8) >> 1); }
constexpr int VTP = SEQ;
struct KVF { bf16x8v k[4], v[4]; };
__device__ __forceinline__ f32x16 qk_mma(const KVF& f, const bf16x8v (&qf)[4]) {
    f32x16 sT;
#pragma unroll
    for (int r = 0; r < 16; ++r) sT[r] = 0.f;
#pragma unroll
    for (int st = 0; st < 4; ++st) sT = MFMA32(f.k[st], qf[st], sT);
    return sT;
}
__device__ __forceinline__ void pv_mma_l(const float (&w)[16], const KVF& f, f32x16& O0, f32x16& O1, f32x16& Ol) {
    v4u p0, p1;
    p0.x = cvtpk(w[0], w[1]); p0.y = cvtpk(w[2], w[3]); p0.z = cvtpk(w[4], w[5]); p0.w = cvtpk(w[6], w[7]);
    p1.x = cvtpk(w[8], w[9]); p1.y = cvtpk(w[10], w[11]); p1.z = cvtpk(w[12], w[13]); p1.w = cvtpk(w[14], w[15]);
    const bf16x8v pa0 = __builtin_bit_cast(bf16x8v, p0), pa1 = __builtin_bit_cast(bf16x8v, p1);
    const bf16x8v ones = {0x3F80, 0x3F80, 0x3F80, 0x3F80, 0x3F80, 0x3F80, 0x3F80, 0x3F80};
    O0 = MFMA32(pa0, f.v[0], O0); O0 = MFMA32(pa1, f.v[1], O0);
    O1 = MFMA32(pa0, f.v[2], O1); O1 = MFMA32(pa1, f.v[3], O1);
    Ol = MFMA32(pa0, ones, Ol); Ol = MFMA32(pa1, ones, Ol);
}
__device__ __forceinline__ void pv_mma(const float (&w)[16], const KVF& f, f32x16& O0, f32x16& O1) {
    v4u p0, p1;
    p0.x = cvtpk(w[0], w[1]); p0.y = cvtpk(w[2], w[3]); p0.z = cvtpk(w[4], w[5]); p0.w = cvtpk(w[6], w[7]);
    p1.x = cvtpk(w[8], w[9]); p1.y = cvtpk(w[10], w[11]); p1.z = cvtpk(w[12], w[13]); p1.w = cvtpk(w[14], w[15]);
    const bf16x8v pa0 = __builtin_bit_cast(bf16x8v, p0), pa1 = __builtin_bit_cast(bf16x8v, p1);
    O0 = MFMA32(pa0, f.v[0], O0); O0 = MFMA32(pa1, f.v[1], O0);
    O1 = MFMA32(pa0, f.v[2], O1); O1 = MFMA32(pa1, f.v[3], O1);
}
struct KVG { v4u k[4], v[4]; };
constexpr int KV_KROW = 144, KV_VROW = 80, KV_V_OFF = 32 * KV_KROW, KV_BYTES = KV_V_OFF + 64 * KV_VROW;
__device__ __forceinline__ void kvg_load(KVG& g, const bf16* ktile  , size_t krow_stride  , const bf16* vtile  , int lane) {
#pragma unroll
    for (int j = 0; j < 4; ++j) g.k[j] = *(const GAS v4u*)(ktile + (size_t)((lane >> 3) + 8 * j) * krow_stride + 8 * (lane & 7));
#pragma unroll
    for (int j = 0; j < 4; ++j) g.v[j] = *(const GAS v4u*)(vtile + (size_t)((lane >> 2) + 16 * j) * VTP + 8 * (lane & 3));
}
__device__ __forceinline__ void kvg_store(const KVG& g, LAS unsigned char* img, int lane) {
#pragma unroll
    for (int j = 0; j < 4; ++j) *(LAS v4u*)(img + ((lane >> 3) + 8 * j) * KV_KROW + 16 * (lane & 7)) = g.k[j];
#pragma unroll
    for (int j = 0; j < 4; ++j) *(LAS v4u*)(img + KV_V_OFF + ((lane >> 2) + 16 * j) * KV_VROW + 16 * (lane & 3)) = g.v[j];
}
__device__ __forceinline__ void kvf_read(KVF& f, const LAS unsigned char* img, int n, int hi) {
    const LAS unsigned char* kp = img + pi32(n) * KV_KROW + 16 * hi;
#pragma unroll
    for (int st = 0; st < 4; ++st) f.k[st] = *(const LAS bf16x8v*)(kp + 32 * st);
    const LAS unsigned char* vp = img + KV_V_OFF + n * KV_VROW + 16 * hi;
#pragma unroll
    for (int db = 0; db < 2; ++db)
#pragma unroll
        for (int s = 0; s < 2; ++s) f.v[2 * db + s] = *(const LAS bf16x8v*)(vp + db * 32 * KV_VROW + 32 * s);
}
__device__ __forceinline__ void sb_mfma(const Frame& F, const bf16* Hc, const bf16* VTS, bf16* Y) {
    const int gw = blockIdx.x * NWAVES + F.wave, NGW = F.G * NWAVES, lane = F.lane, n = lane & 31, hi = lane >> 5;
    LAS unsigned char* img = F.lds + RING_OFF + F.wave * 16384;
    for (int it = gw; it < BC * 8 * 64; it += NGW) {
        const int qt = it & 63, h = (it >> 6) & 7, bl = it >> 9;
        const int q0 = qt * 32, t = q0 + n;
        const bf16* base = Hc + (size_t)bl * SEQ * HP;
        bf16x8v qf[4];
        { const bf16* qp = base + (size_t)t * HP + C_SBQ + h * 64 + 8 * hi;
#pragma unroll
          for (int st = 0; st < 4; ++st) qf[st] = *(const GAS bf16x8v*)(qp + 16 * st); }
        f32x16 O0, O1;
#pragma unroll
        for (int r = 0; r < 16; ++r) { O0[r] = 0.f; O1[r] = 0.f; }
        float R = 0.f;
        const bf16* kt0 = base + C_SBK + h * 64; const bf16* vt0 = VTS + (size_t)((bl * 8 + h) * 64) * VTP;
        { KVG g; kvg_load(g, kt0 + (size_t)(qt * 32) * HP, HP, vt0 + qt * 32, lane); kvg_store(g, img, lane); }
        for (int kt = qt; kt >= 0; --kt) {
            const int k0 = kt * 32;
            KVG g; { const int kn = kt > 0 ? kt - 1 : 0; kvg_load(g, kt0 + (size_t)(kn * 32) * HP, HP, vt0 + kn * 32, lane); }
            KVF cur; kvf_read(cur, img, n, hi);
            const f32x16 sT = qk_mma(cur, qf);
            float L[16], w[16];
#pragma unroll
            for (int r = 0; r < 16; ++r) { const int key = k0 + (r & 7) + 8 * hi + 16 * (r >> 3); const float z = sT[r];
                const float sp = fmaxf(z, 0.f) + lg2(1.f + ex2(-fabsf(z))); L[r] = (key < t) ? sp : 0.f; }
            float A0 = 0.f, A1 = 0.f;
#pragma unroll
            for (int r = 0; r < 8; ++r) { A0 += L[r]; A1 += L[8 + r]; }
            const float PA0 = __shfl_xor(A0, 32), PA1 = __shfl_xor(A1, 32);
            { float run = R + (hi ? 0.f : PA1);
#pragma unroll
              for (int r = 15; r >= 8; --r) { const int key = k0 + (r & 7) + 8 * hi + 16; w[r] = (key < t) ? ex2(sT[r] - L[r] - run) : 0.f; run += L[r]; }
              run = R + PA1 + A1 + (hi ? 0.f : PA0);
#pragma unroll
              for (int r = 7; r >= 0; --r) { const int key = k0 + r + 8 * hi; w[r] = (key < t) ? ex2(sT[r] - L[r] - run) : 0.f; run += L[r]; } }
            R += (A0 + A1) + (PA0 + PA1);
            v4u p0, p1;
            p0.x = cvtpk(w[0], w[1]); p0.y = cvtpk(w[2], w[3]); p0.z = cvtpk(w[4], w[5]); p0.w = cvtpk(w[6], w[7]);
            p1.x = cvtpk(w[8], w[9]); p1.y = cvtpk(w[10], w[11]); p1.z = cvtpk(w[12], w[13]); p1.w = cvtpk(w[14], w[15]);
            const bf16x8v pa0 = __builtin_bit_cast(bf16x8v, p0), pa1 = __builtin_bit_cast(bf16x8v, p1);
            O0 = MFMA32(pa0, cur.v[0], O0); O0 = MFMA32(pa1, cur.v[1], O0);
            O1 = MFMA32(pa0, cur.v[2], O1); O1 = MFMA32(pa1, cur.v[3], O1);
            if (__all(R >= 40.f)) break;
            kvg_store(g, img, lane);
        }
        bf16* yp = Y + (size_t)(bl * SEQ + q0) * 512 + h * 64 + n;
#pragma unroll
        for (int r = 0; r < 16; ++r) { bf16* rp = yp + (size_t)crow(r, hi) * 512; rp[0] = (bf16)f2bf(O0[r]); rp[32] = (bf16)f2bf(O1[r]); }
    }
}

__device__ __forceinline__ float row_ref(const f32x16& sT) {
    float a = sT[0];
#pragma unroll
    for (int r = 1; r < 16; ++r) a = fmaxf(a, sT[r]);
    return fmaxf(a, __shfl_xor(a, 32));
}
__device__ __forceinline__ void datt_mfma(const Frame& F, const bf16* Hc, const bf16* VTA, const unsigned* MASK32, bf16* Y, const float* rel_bias, LAS float* lut) {
    const int gw = blockIdx.x * NWAVES + F.wave, NGW = F.G * NWAVES, lane = F.lane, n = lane & 31, hi = lane >> 5;
    LAS unsigned char* img = F.lds + RING_OFF + F.wave * 16384;
    for (int i = F.tid; i < 8 * 128; i += NWAVES * 64) lut[i] = rel_bias[t5_bucket(i & 127) * 20 + 12 + (i >> 7)] * LOG2E;
    LDS_WAIT(); __syncthreads();
    for (int it = gw; it < BC * 8 * 32; it += NGW) {
        const int qp_ = it & 31, h = (it >> 5) & 7, bl = it >> 8;
        const bf16* base = Hc + (size_t)bl * SEQ * HP;
        const LAS float* lh = lut + h * 128;
        for (int half = 0; half < 2; ++half) {
            const int qt = half ? 63 - qp_ : qp_, q0 = qt * 32, t = q0 + n;
            bf16x8v qf[4];
            { const bf16* qp = base + (size_t)t * HP + C_AQ + h * 64 + 8 * hi;
#pragma unroll
              for (int st = 0; st < 4; ++st) qf[st] = *(const GAS bf16x8v*)(qp + 16 * st); }
            const bf16* kt0 = base + C_AK + h * 64; const bf16* vt0 = VTA + (size_t)((bl * 8 + h) * 64) * VTP;
            const unsigned* mrow = MASK32 + (size_t)(bl * SEQ + t) * 64;
            f32x16 O0, O1;
#pragma unroll
            for (int r = 0; r < 16; ++r) { O0[r] = 0.f; O1[r] = 0.f; }
            f32x16 Ol;
#pragma unroll
            for (int r = 0; r < 16; ++r) Ol[r] = 0.f;
            float mref = 0.f;
            { KVG g; kvg_load(g, kt0, HP, vt0, lane); kvg_store(g, img, lane); } unsigned mw = mrow[0];
            for (int kt = 0; kt <= qt; ++kt) {
                const int k0 = kt * 32;
                KVG g; const int kn = kt < qt ? kt + 1 : qt; kvg_load(g, kt0 + (size_t)(kn * 32) * HP, HP, vt0 + kn * 32, lane); const unsigned mwn = mrow[kn];
                KVF cur; kvf_read(cur, img, n, hi);
                const f32x16 sT = qk_mma(cur, qf);
                if (kt == 0) mref = row_ref(sT);
                float w[16];
                const unsigned mwh = mw >> (8 * hi);
                if (k0 + 31 + 113 <= q0) {
                    const float cb = lh[127] - mref;
#pragma unroll
                    for (int r = 0; r < 16; ++r) { const float p = ex2(sT[r] + cb); const unsigned sel = (unsigned)__builtin_amdgcn_sbfe((int)mwh, (r & 7) + 16 * (r >> 3), 1);
                        w[r] = __uint_as_float(__float_as_uint(p) & sel); }
                } else {
#pragma unroll
                    for (int r = 0; r < 16; ++r) { const int ko = (r & 7) + 8 * hi + 16 * (r >> 3); int dist = t - (k0 + ko); dist = dist < 0 ? 0 : (dist > 127 ? 127 : dist);
                        const float p = ex2(sT[r] + lh[dist] - mref); w[r] = ((mwh >> ((r & 7) + 16 * (r >> 3))) & 1u) ? p : 0.f; }
                }
                pv_mma_l(w, cur, O0, O1, Ol);
                kvg_store(g, img, lane); mw = mwn;
            }
            bf16* yp = Y + (size_t)(bl * SEQ + q0 + 4 * hi) * 512 + h * 64 + n;
#pragma unroll
            for (int r = 0; r < 16; ++r) { const int ro = (r & 3) + 8 * (r >> 2); const float rr = 1.f / Ol[r]; bf16* rp = yp + (size_t)ro * 512; rp[0] = (bf16)f2bf(O0[r] * rr); rp[32] = (bf16)f2bf(O1[r] * rr); }
        }
    }
    __syncthreads();
}

__device__ __forceinline__ void dil_mfma(const Frame& F, const bf16* Hc, const bf16* VTD, bf16* Y, const float* rel_bias, LAS float* lut) {
    const int gw = blockIdx.x * NWAVES + F.wave, NGW = F.G * NWAVES, lane = F.lane, n = lane & 31, hi = lane >> 5;
    LAS unsigned char* img = F.lds + RING_OFF + F.wave * 16384;
    for (int i = F.tid; i < 12 * 132; i += NWAVES * 64) { const int d = i % 132, gh = i / 132, g = gh >> 2; lut[i] = (d <= 128) ? rel_bias[t5_bucket(d << (2 * g)) * 20 + gh] * LOG2E : 0.f; }
    LDS_WAIT(); __syncthreads();
    for (int it = gw; it < BC * 4 * 16 * 4; it += NGW) {
        const int ib = it & 3, c16 = (it >> 2) & 15, hs = (it >> 6) & 3, bl = it >> 8;
        const bf16* base = Hc + (size_t)bl * SEQ * HP;
        f32x16 O0, O1;
#pragma unroll
        for (int r = 0; r < 16; ++r) { O0[r] = 0.f; O1[r] = 0.f; }
        f32x16 Ol;
#pragma unroll
        for (int r = 0; r < 16; ++r) Ol[r] = 0.f;
        float mref = 0.f; bool first = true;
        for (int g = 2; g >= 0; --g) {
            const int sh = 2 * g, r_ = 1 << sh, head = g * 4 + hs, cls = c16 & (r_ - 1);
            const int pq0 = (c16 >> sh) + (16 >> sh) * 32 * ib, pstep = 16 >> sh;
            const int pq = pq0 + pstep * n, tq = c16 + 16 * (32 * ib + n);
            bf16x8v qf[4];
            { const bf16* qp = base + (size_t)tq * HP + C_DQ + head * 64 + 8 * hi;
#pragma unroll
              for (int st = 0; st < 4; ++st) qf[st] = *(const GAS bf16x8v*)(qp + 16 * st); }
            const bf16* kt0 = base + (size_t)cls * HP + C_DK + head * 64;
            const bf16* vt0 = VTD + (size_t)((bl * 12 + head) * 64) * VTP + cls * (SEQ >> sh);
            const LAS float* lh = lut + head * 132;
            int klo = pq0 - 128; klo = klo < 0 ? 0 : (klo >> 5);
            const int khi = (pq0 + pstep * 31) >> 5;
            { KVG g; kvg_load(g, kt0 + (size_t)(r_ * klo * 32) * HP, (size_t)r_ * HP, vt0 + klo * 32, lane); kvg_store(g, img, lane); }
            for (int kt = klo; kt <= khi; ++kt) {
                const int k0 = kt * 32;
                KVG g; { const int kn = kt < khi ? kt + 1 : khi; kvg_load(g, kt0 + (size_t)(r_ * kn * 32) * HP, (size_t)r_ * HP, vt0 + kn * 32, lane); }
                KVF cur; kvf_read(cur, img, n, hi);
                const f32x16 sT = qk_mma(cur, qf);
                if (first) { mref = row_ref(sT); first = false; }
                float w[16];
#pragma unroll
                for (int r = 0; r < 16; ++r) { const int ko = (r & 7) + 8 * hi + 16 * (r >> 3); const int dist = pq - (k0 + ko); const bool valid = (dist >= 0) && (dist <= 128);
                    const int dc = dist < 0 ? 0 : (dist > 128 ? 128 : dist);
                    const float p = ex2(sT[r] + lh[dc] - mref); w[r] = valid ? p : 0.f; }
                pv_mma_l(w, cur, O0, O1, Ol);
                kvg_store(g, img, lane);
            }
        }
        bf16* yp = Y + (size_t)(bl * SEQ + c16 + 512 * ib + 64 * hi) * 256 + hs * 64 + n;
#pragma unroll
        for (int r = 0; r < 16; ++r) { const int ro = (r & 3) + 8 * (r >> 2); const float rr = 1.f / Ol[r]; bf16* rp = yp + (size_t)(16 * ro) * 256; rp[0] = (bf16)f2bf(O0[r] * rr); rp[32] = (bf16)f2bf(O1[r] * rr); }
    }
    __syncthreads();
}

#if MK_PROBE
#define SSM_T0(id) do { if ((id) == PROBE_REGION && F.wave == 0) { int l_; asm volatile("v_mbcnt_lo_u32_b32 %0, -1, 0\n\tv_mbcnt_hi_u32_b32 %0, -1, %0" : "=v"(l_)); if (l_ == 0) PR[2] = __builtin_amdgcn_s_memrealtime(); } } while (0)
#define SSM_T1(id) do { if ((id) == PROBE_REGION && F.wave == 0) { int l_; asm volatile("v_mbcnt_lo_u32_b32 %0, -1, 0\n\tv_mbcnt_hi_u32_b32 %0, -1, %0" : "=v"(l_)); if (l_ == 0) PR[1] += __builtin_amdgcn_s_memrealtime() - PR[2]; } } while (0)
#else
#define SSM_T0(id) do { } while (0)
#define SSM_T1(id) do { } while (0)
#endif
__device__ __forceinline__ void dsel_mfma(const Frame& F, const bf16* Hc, unsigned* MASK32, LAS unsigned* part  , LAS unsigned char* qimg  ) {
    const int lane = F.lane, n = lane & 31, hi = lane >> 5, w = F.wave;
    for (int i_ = blockIdx.x * (NWAVES * 64) + F.tid; ; i_ += F.G * NWAVES * 64) { int i = i_; asm volatile("" : "+v"(i)); if (i >= BC * 256 * 8) break;
        const int word = i & 7, t = (i >> 3) & 255, bl = i >> 11; const int nb = t + 1 - 32 * word;
        MASK32[(size_t)(bl * SEQ + t) * 64 + word] = nb >= 32 ? 0xFFFFFFFFu : (nb <= 0 ? 0u : ((1u << nb) - 1u)); }
    volatile LAS unsigned long long* PR = (volatile LAS unsigned long long*)(F.lds + MISC_OFF + 64);
    int pp = 0; LAS unsigned* hist = (LAS unsigned*)(qimg + 36864);
#define WG_REDUCE(cexpr, out) do { unsigned c_ = (cexpr); c_ += __shfl_xor(c_, 32); if (hi == 0) part[pp * 256 + w * 32 + n] = c_; LDS_WAIT(); __syncthreads(); unsigned t_ = 0; \
        _Pragma("unroll") for (int ww = 0; ww < 8; ++ww) t_ += part[pp * 256 + ww * 32 + n]; out = t_; pp ^= 1; } while (0)
    for (int u = blockIdx.x; u < BC * 56; u += F.G) {
        const int qt = (u < 256) ? 63 - (u >> 3) : 8 + ((u - 256) >> 3), bl = u & 7;
        const int q0 = 32 * qt, t = q0 + n;
        const bf16* base = Hc + (size_t)bl * SEQ * HP;
        const bf16* qrow = base + (size_t)t * HP;
        const bf16* kb = base + (size_t)pi32(n) * HP + C_IK + 8 * hi;
        const int ntl = ((qt - w) >> 3) + 1;
        SSM_T0(20);
        __syncthreads();
        for (int i = F.tid; i < 8224 / 4; i += NWAVES * 64) ((LAS v4u*)hist)[i] = (v4u){0u, 0u, 0u, 0u};
        { const int qq = F.tid >> 4, part4 = F.tid & 15; const bf16* src = base + (size_t)(q0 + qq) * HP + C_IQ + part4 * 32; LAS unsigned char* dq = qimg + qq * 1040 + part4 * 64;
#pragma unroll
          for (int k = 0; k < 4; ++k) *(LAS v4u*)(dq + 16 * k) = *(const GAS v4u*)(src + 8 * k); }
        if (F.tid < 32) { float wq[8]; ld8(base + (size_t)(q0 + F.tid) * HP + C_IW, wq); LAS float* wd = (LAS float*)(qimg + 33280) + F.tid * 9;
#pragma unroll
          for (int k = 0; k < 8; ++k) wd[k] = wq[k]; }
        LDS_WAIT(); __syncthreads(); SSM_T1(20); SSM_T0(21);
        const LAS float* wl = (const LAS float*)(qimg + 33280) + n * 9;
        float sc[8][16];
#pragma unroll
        for (int i = 0; i < 8; ++i)
#pragma unroll
            for (int r = 0; r < 16; ++r) sc[i][r] = 0.f;
        const LAS unsigned char* qb = qimg + n * 1040 + 16 * hi;
        bf16x8v kc[4];
#pragma unroll
        for (int st = 0; st < 4; ++st) kc[st] = *(const GAS bf16x8v*)(kb + (size_t)(32 * w) * HP + 16 * st);
#pragma unroll
        for (int i = 0; i < 8; ++i) if (i < ntl) {
            bf16x8v kn[4]; { const int in = (i + 1 < ntl) ? i + 1 : i;
#pragma unroll
              for (int st = 0; st < 4; ++st) kn[st] = *(const GAS bf16x8v*)(kb + (size_t)(32 * (w + 8 * in)) * HP + 16 * st); }
#pragma unroll
            for (int hh = 0; hh < 8; ++hh) {
                f32x16 sT;
#pragma unroll
                for (int r = 0; r < 16; ++r) sT[r] = 0.f;
#pragma unroll
                for (int st = 0; st < 4; ++st) { const bf16x8v qf = *(const LAS bf16x8v*)(qb + hh * 128 + st * 32); sT = MFMA32(kc[st], qf, sT); }
                const float wh = wl[hh];
#pragma unroll
                for (int r = 0; r < 16; ++r) sc[i][r] += wh * fmaxf(sT[r], 0.f);
            }
#pragma unroll
            for (int st = 0; st < 4; ++st) kc[st] = kn[st];
        }
        SSM_T1(21); SSM_T0(22);
        unsigned key[8][16];
        int pbase = 8 * hi + 32 * w; asm volatile("" : "+v"(pbase));
        const int lim = t - pbase;
#pragma unroll
        for (int i = 0; i < 8; ++i)
#pragma unroll
            for (int r = 0; r < 16; ++r) key[i][r] = (i < ntl && (256 * i + (r & 7) + 16 * (r >> 3)) <= lim) ? fkey(sc[i][r] + 0.f) : 0u;
        unsigned tau = 0u; int above = 0, ceq = 0;
#pragma unroll 1
        for (int ps = 0; ps < 4; ++ps) {
            const int s = 24 - 8 * ps; LAS unsigned* hb = hist + (ps & 1) * 8224 + n;
#pragma unroll
            for (int i = 0; i < 8; ++i) if (i < ntl) {
#pragma unroll
                for (int r = 0; r < 16; ++r) { const unsigned k = key[i][r]; const bool match = ((k >> s) >> 8) == tau; const unsigned bin = match ? ((k >> s) & 255u) : 256u;
                    (void)__hip_atomic_fetch_add(hb + bin * 32, 1u, __ATOMIC_RELAXED, __HIP_MEMORY_SCOPE_WORKGROUP); } }
            LDS_WAIT(); __syncthreads();
            { const int j = 2 * w + hi; unsigned sj = 0u;
#pragma unroll
              for (int b2 = 0; b2 < 16; ++b2) sj += hb[(16 * j + b2) * 32];
              part[j * 32 + n] = sj;
              LAS v4u* hz = (LAS v4u*)(hist + ((ps + 1) & 1) * 8224); for (int i = F.tid; i < 8224 / 4; i += NWAVES * 64) hz[i] = (v4u){0u, 0u, 0u, 0u}; }
            LDS_WAIT(); __syncthreads();
            int cum = above, jsel = 0; bool found = false;
#pragma unroll
            for (int j = 15; j >= 0; --j) { const int h = (int)part[j * 32 + n]; const bool hit = !found && (cum + h >= 256); jsel = hit ? j : jsel; found = found || hit; cum += found ? 0 : h; }
            int chosen = 0, hsel = 0; found = false;
#pragma unroll
            for (int b2 = 15; b2 >= 0; --b2) { const int h = (int)hb[(16 * jsel + b2) * 32]; const bool hit = !found && (cum + h >= 256); chosen = hit ? b2 : chosen; hsel = hit ? h : hsel; found = found || hit; cum += found ? 0 : h; }
            above = cum; ceq = hsel; tau = (tau << 8) | (unsigned)(16 * jsel + chosen);
        }
        SSM_T1(22); SSM_T0(23);
        const int need = 256 - above;
        unsigned anyw = (unsigned)__any(ceq != need);
        int X = 4096;
        if (anyw) {
            X = 0;
            for (int b = 11; b >= 0; --b) {
                const int Xc = X | (1 << b), Xl = Xc - pbase; unsigned c = 0u;
#pragma unroll
                for (int i = 0; i < 8; ++i) if (i < ntl) {
#pragma unroll
                    for (int r = 0; r < 16; ++r) c += (key[i][r] == tau && (256 * i + (r & 7) + 16 * (r >> 3)) < Xl) ? 1u : 0u; }
                unsigned tot; WG_REDUCE(c, tot);
                if ((int)tot <= need) X = Xc;
            }
        }
        const int Xf = X - pbase;
#pragma unroll
        for (int i = 0; i < 8; ++i) if (i < ntl) {
            unsigned word = 0u;
#pragma unroll
            for (int r = 0; r < 16; ++r) { const bool sel = (key[i][r] > tau) || (key[i][r] == tau && (256 * i + (r & 7) + 16 * (r >> 3)) < Xf); word |= sel ? (1u << ((r & 7) + 16 * (r >> 3))) : 0u; }
            word <<= 8 * hi;
            word |= __shfl_xor(word, 32);
            if (hi == 0) MASK32[(size_t)(bl * SEQ + t) * 64 + (w + 8 * i)] = word;
        }
        SSM_T1(23);
    }
#undef WG_REDUCE
}

constexpr size_t SSM_APOW = 0, SSM_BT = 576 * 1024, SSM_KT = 832 * 1024, SSM_GT = 2 * MiB, SSM_HT = 6 * MiB;
typedef float f32x2v __attribute__((ext_vector_type(2)));
__device__ __forceinline__ void apow_phase(const Frame& F, const SsmPtrs& S, unsigned char* T) {
    f32x2v* APOW = (f32x2v*)(T + SSM_APOW); f32x2v* BT = (f32x2v*)(T + SSM_BT);
    const int gtid = blockIdx.x * (NWAVES * 64) + F.tid, NT = F.G * NWAVES * 64;
    for (int e = gtid; e < 32 * 33 * 64; e += NT) { const int p = e & 63, k = (e >> 6) % 33, g = e / (33 * 64);
        const float lr = S.lam_re[g * 64 + p], li = S.lam_im[g * 64 + p], dt = expf(S.log_dt[g]);
        const float mag = expf((float)k * (lr * dt)), ang = (float)k * (li * dt); APOW[e] = (f32x2v){mag * cosf(ang), mag * sinf(ang)}; }
    for (int e = gtid; e < 32 * 64 * 16; e += NT) { const int p = (e >> 4) & 63, g = e >> 10;
        const float lr = S.lam_re[g * 64 + p], li = S.lam_im[g * 64 + p], dt = expf(S.log_dt[g]);
        const float mag = expf(lr * dt), a_re = mag * cosf(li * dt), a_im = mag * sinf(li * dt);
        const float den = lr * lr + li * li, f_re = ((a_re - 1.f) * lr + a_im * li) / den, f_im = (a_im * lr - (a_re - 1.f) * li) / den;
        const float br = S.b_re[e], bi = S.b_im[e]; BT[e] = (f32x2v){f_re * br - f_im * bi, f_re * bi + f_im * br}; }
}
__device__ __forceinline__ void ssm_tables_phase(const Frame& F, const SsmPtrs& S, unsigned char* T) {
    const f32x2v* APOW = (const f32x2v*)(T + SSM_APOW); const f32x2v* BT = (const f32x2v*)(T + SSM_BT);
    bf16* KT = (bf16*)(T + SSM_KT); bf16* GT = (bf16*)(T + SSM_GT); bf16* HT = (bf16*)(T + SSM_HT);
    const int gtid = blockIdx.x * (NWAVES * 64) + F.tid, NT = F.G * NWAVES * 64;
    for (int e = gtid; e < 32 * 32 * 128 * 16; e += NT) {
        const int c = e & 15, pp = (e >> 4) & 127, sig = (e >> 11) & 31, g = e >> 16, p = pp & 63;
        const f32x2v ap = APOW[(g * 33 + (31 - sig)) * 64 + p], bt = BT[(g * 64 + p) * 16 + c];
        GT[e] = (bf16)f2bf((pp >> 6) ? (ap.x * bt.y + ap.y * bt.x) : (ap.x * bt.x - ap.y * bt.y)); }
    for (int e = gtid; e < 32 * 32 * 16 * 128; e += NT) {
        const int k = e & 127, c = (e >> 7) & 15, tau = (e >> 11) & 31, g = e >> 16, p = k & 63;
        const f32x2v ap = APOW[(g * 33 + tau + 1) * 64 + p]; const float cr = S.c_re[(g * 16 + c) * 64 + p], ci = S.c_im[(g * 16 + c) * 64 + p];
        HT[e] = (bf16)f2bf((k >> 6) ? -(cr * ap.y + ci * ap.x) : (cr * ap.x - ci * ap.y)); }
    for (int e = gtid; e < 32 * 32 * 16 * 16; e += NT) {
        const int c2 = e & 15, c = (e >> 4) & 15, k = (e >> 8) & 31, g = e >> 13; float acc = 0.f;
        for (int p = 0; p < 64; ++p) { const f32x2v ap = APOW[(g * 33 + k) * 64 + p], bt = BT[(g * 64 + p) * 16 + c2]; const float cr = S.c_re[(g * 16 + c) * 64 + p], ci = S.c_im[(g * 16 + c) * 64 + p];
            const float mr = ap.x * bt.x - ap.y * bt.y, mi = ap.x * bt.y + ap.y * bt.x; acc += cr * mr - ci * mi; }
        KT[e] = (bf16)f2bf(acc); }
}
constexpr int SSM_UROW = 1040, SSM_U_OFF = 0, SSM_P_OFF = 64 * SSM_UROW, SSM_PROW = 516, SSM_S_OFF = SSM_P_OFF + 64 * SSM_PROW, SSM_SROW = 272;
static_assert(SSM_S_OFF % 16 == 0 && SSM_S_OFF + 64 * SSM_SROW <= RING_BYTES, "ssm LDS map");
__device__ __forceinline__ void ssm_mfma(const Frame& F, const bf16* Hc, bf16* YG, const float* dskip, const unsigned char* T) {
    const int lane = F.lane, n = lane & 31, hi = lane >> 5, w = F.wave;
    LAS unsigned char* L = F.lds + RING_OFF;
    const f32x2v* APOW = (const f32x2v*)(T + SSM_APOW);
    volatile LAS unsigned long long* PR = (volatile LAS unsigned long long*)(F.lds + MISC_OFF + 64);
    for (int u = blockIdx.x; u < BC * 32; u += F.G) {
        const int g = u & 31, bl = u >> 5;
        SSM_T0(10);
        const bf16* KT = (const bf16*)(T + SSM_KT) + (size_t)g * 32 * 256; const bf16* GT = (const bf16*)(T + SSM_GT) + (size_t)g * 65536; const bf16* HT = (const bf16*)(T + SSM_HT) + (size_t)g * 65536;
#pragma unroll
        for (int k = 0; k < 4; ++k) { const int tok = F.tid + 512 * k; const bf16* up = Hc + (size_t)(bl * SEQ + tok) * HP + C_U + 16 * g;
            const v4u a = *(const GAS v4u*)up, b = *(const GAS v4u*)(up + 8); LAS unsigned char* d = L + SSM_U_OFF + (tok >> 5) * SSM_UROW + (tok & 31) * 32;
            *(LAS v4u*)d = a; *(LAS v4u*)(d + 16) = b; }
        const v4u kt0 = *(const GAS v4u*)(KT + F.tid * 16), kt1 = *(const GAS v4u*)(KT + F.tid * 16 + 8);
        LDS_WAIT(); __syncthreads(); SSM_T1(10); SSM_T0(11);
        { const int rt = w >> 1, ct = w & 1; f32x16 acc;
#pragma unroll
          for (int r = 0; r < 16; ++r) acc[r] = 0.f;
          const bf16* gp = GT + (size_t)(32 * rt + n) * 16 + 8 * hi; const LAS unsigned char* ub = L + SSM_U_OFF + (32 * ct + n) * SSM_UROW + 16 * hi;
#pragma unroll
          for (int sb = 0; sb < 32; sb += 16) { bf16x8v a[16];
#pragma unroll
            for (int k = 0; k < 16; ++k) a[k] = *(const GAS bf16x8v*)(gp + (size_t)(sb + k) * 2048);
#pragma unroll
            for (int k = 0; k < 16; ++k) { const bf16x8v b = *(const LAS bf16x8v*)(ub + (sb + k) * 32); acc = MFMA32(a[k], b, acc); } }
          LAS float* pl = (LAS float*)(L + SSM_P_OFF + (32 * ct + n) * SSM_PROW) + 32 * rt;
#pragma unroll
          for (int r = 0; r < 16; ++r) pl[crow(r, hi)] = acc[r]; }
        LDS_WAIT(); __syncthreads(); SSM_T1(11); SSM_T0(12);
        if (w == 0) { const f32x2v a32 = APOW[(g * 33 + 32) * 64 + lane]; float sr = 0.f, si = 0.f;
#pragma unroll 1
            for (int jb = 0; jb < 64; jb += 16) { float pr[16], pi[16];
#pragma unroll
                for (int k = 0; k < 16; ++k) { const LAS float* pl = (const LAS float*)(L + SSM_P_OFF + (jb + k) * SSM_PROW); pr[k] = pl[lane]; pi[k] = pl[64 + lane]; }
#pragma unroll
                for (int k = 0; k < 16; ++k) { LAS bf16* sl = (LAS bf16*)(L + SSM_S_OFF + (jb + k) * SSM_SROW); sl[lane] = (bf16)f2bf(sr); sl[64 + lane] = (bf16)f2bf(si);
                    const float nr = a32.x * sr - a32.y * si + pr[k], ni = a32.x * si + a32.y * sr + pi[k]; sr = nr; si = ni; } } }
        LDS_WAIT(); __syncthreads();
        { LAS unsigned char* kd = L + SSM_P_OFF + F.tid * 32; *(LAS v4u*)kd = kt0; *(LAS v4u*)(kd + 16) = kt1; }
        LDS_WAIT(); __syncthreads(); SSM_T1(12); SSM_T0(13);
#pragma unroll 1
        for (int q = 0; q < 4; ++q) {
            const int rt = (q < 2) ? w : 15 - w, ct = q & 1; f32x16 acc;
#pragma unroll
            for (int r = 0; r < 16; ++r) acc[r] = 0.f;
            const int tl = 2 * rt + (n >> 4), cl = n & 15;
            const LAS unsigned char* ub = L + SSM_U_OFF + (32 * ct + n) * SSM_UROW + 16 * hi;
            const bf16* hp = HT + (size_t)(tl * 16 + cl) * 128 + 8 * hi; const LAS unsigned char* sb = L + SSM_S_OFF + (32 * ct + n) * SSM_SROW + 16 * hi;
            bf16x8v ha[8];
#pragma unroll
            for (int ks = 0; ks < 8; ++ks) ha[ks] = *(const GAS bf16x8v*)(hp + 16 * ks);
            const LAS unsigned char* kp = L + SSM_P_OFF + cl * 32 + 16 * hi;
            for (int sig = 0; sig <= 2 * rt + 1; sig += 2) {
                const int lag0 = tl - sig, lag1 = lag0 - 1;
                bf16x8v a0 = *(const LAS bf16x8v*)(kp + (lag0 < 0 ? 0 : lag0) * 512), a1 = *(const LAS bf16x8v*)(kp + (lag1 < 0 ? 0 : lag1) * 512);
                if (lag0 < 0) a0 = (bf16x8v){0, 0, 0, 0, 0, 0, 0, 0};
                if (lag1 < 0) a1 = (bf16x8v){0, 0, 0, 0, 0, 0, 0, 0};
                const bf16x8v b0 = *(const LAS bf16x8v*)(ub + sig * 32), b1 = *(const LAS bf16x8v*)(ub + sig * 32 + 32); acc = MFMA32(a0, b0, acc); acc = MFMA32(a1, b1, acc); }
#pragma unroll
            for (int ks = 0; ks < 8; ++ks) { const bf16x8v b = *(const LAS bf16x8v*)(sb + 32 * ks); acc = MFMA32(ha[ks], b, acc); }
            const f32x4 d0 = *(const GAS f32x4*)(dskip + 16 * g + 4 * hi), d1 = *(const GAS f32x4*)(dskip + 16 * g + 8 + 4 * hi);
            const LAS unsigned short* uimg = (const LAS unsigned short*)(L + SSM_U_OFF + (32 * ct + n) * SSM_UROW);
#pragma unroll
            for (int half = 0; half < 2; ++half)
#pragma unroll
                for (int cq = 0; cq < 2; ++cq) {
                    float o[4];
#pragma unroll
                    for (int i = 0; i < 4; ++i) { const int r = 8 * half + 4 * cq + i; const int tau = 2 * rt + half, c = i + 8 * cq + 4 * hi;
                        const float uu = __uint_as_float((unsigned)uimg[tau * 16 + c] << 16); const float dd = cq ? d1[i] : d0[i];
                        const float y = acc[r] + dd * uu; const float z = 0.7978845608028654f * (y + 0.044715f * y * y * y);
                        const float th = 1.f - 2.f * __builtin_amdgcn_rcpf(1.f + ex2(2.f * LOG2E * z)); o[i] = 0.5f * y * (1.f + th); }
                    const unsigned long long wv = (unsigned long long)pk2(o[0], o[1]) | ((unsigned long long)pk2(o[2], o[3]) << 32);
                    *(GAS unsigned long long*)(YG + (size_t)(bl * SEQ + 32 * (32 * ct + n) + 2 * rt + half) * 512 + 16 * g + 8 * cq + 4 * hi) = wv; }
        }
        LDS_WAIT(); __syncthreads(); SSM_T1(13);
    }
}
__device__ __forceinline__ bool stage_enter(Frame& F) { int l_; asm volatile("v_mbcnt_lo_u32_b32 %0, -1, 0\n\tv_mbcnt_hi_u32_b32 %0, -1, %0" : "=v"(l_)); F.lane = l_; F.tid = F.wave * 64 + l_; return true; }
struct Args { const float* in[23]; float* out; unsigned char* ws; int lo, hi, use_bar, pad; };
__global__ void __launch_bounds__(NWAVES * 64, 2) fwd_kernel(Args args) {
    extern __shared__ __attribute__((aligned(16))) unsigned char lds[];
    Frame F;
    F.lds = (LAS unsigned char*)lds; F.tid = threadIdx.x; F.lane = F.tid & 63; F.wave = __builtin_amdgcn_readfirstlane(F.tid >> 6); F.G = gridDim.x;
    volatile LAS unsigned* MISC = (volatile LAS unsigned*)(F.lds + MISC_OFF);
    unsigned char* ws = args.ws;
    gu32* ctl = (gu32*)(ws + WS_CTL);
    for (int u = F.tid; u < (LDS_BYTES - LDSCTL_OFF) / 4; u += NWAVES * 64) ((LAS unsigned*)(F.lds + LDSCTL_OFF))[u] = 0u;
    __syncthreads();
    XcdBarrier bar; bar.bar = (unsigned*)(ctl + CW_BAR); bar.x = 0; bar.st = nullptr;
    if (args.use_bar) bar = xcd_barrier_post((unsigned*)(ctl + CW_BAR), MISC + 8);
    const int lo = args.lo, hi = args.hi;
    int st = 0;
#define STAGE_IF (lo <= st && st < hi && stage_enter(F))
#if MK_PROBE
    volatile LAS unsigned long long* PR = (volatile LAS unsigned long long*)(MISC + 16);
    if (F.tid == 0) { PR[0] = __builtin_amdgcn_s_memrealtime(); PR[1] = 0ull; }
#define STAGE_END_T(ty) do { const unsigned long long t0_ = __builtin_amdgcn_s_memrealtime(); xcd_barrier(bar); stage_enter(F); if (F.tid == 0) { const unsigned long long t1_ = __builtin_amdgcn_s_memrealtime(); \
        if (PROBE_REGION < 0 && ((PROBE_SEL >> (ty)) & 1)) PR[1] += (PROBE_KIND == 0) ? (t1_ - PR[0]) : (t1_ - t0_); PR[0] = t1_; } } while (0)
#ifndef PROBE_REGION
#define PROBE_REGION 23
#endif
#define PROBE_T0(id) do { if ((id) == PROBE_REGION) { stage_enter(F); if (F.tid == 0) PR[2] = __builtin_amdgcn_s_memrealtime(); } } while (0)
#define PROBE_T1(id) do { if ((id) == PROBE_REGION) { stage_enter(F); if (F.tid == 0) PR[1] += __builtin_amdgcn_s_memrealtime() - PR[2]; } } while (0)
#else
#define STAGE_END_T(ty) do { if (st + 1 < hi) { xcd_barrier(bar); } } while (0)
#define PROBE_T0(id) do { } while (0)
#define PROBE_T1(id) do { } while (0)
#endif
#define STAGE_END STAGE_END_T(0)
    bf16* WT = (bf16*)(ws + WS_WT); bf16* XB = (bf16*)(ws + WS_XB); bf16* MG = (bf16*)(ws + WS_MG); bf16* HB = (bf16*)(ws + WS_H);
    bf16* YSB = (bf16*)(ws + WS_YSB); bf16* YDIL = (bf16*)(ws + WS_YDIL); bf16* YSSM = (bf16*)(ws + WS_YSSM); bf16* YDSA = (bf16*)(ws + WS_YDSA); bf16* YG = (bf16*)(ws + WS_YG);
    unsigned long long* MASK = (unsigned long long*)(ws + WS_MASK);
    bf16* GTL = (bf16*)(ws + WS_GT);
    bf16* VTS = (bf16*)(ws + WS_VTS); bf16* VTD = (bf16*)(ws + WS_VTD); bf16* VTA = (bf16*)(ws + WS_VTA);
    float* X = args.out;
    const float* rel_bias = args.in[6];

    for (int layer = 0; layer < DEPTH; ++layer) {
        if (STAGE_IF) {
            WPtrs P; P.up1 = args.in[3] + (size_t)layer * D * NUP; P.dn1 = args.in[4] + (size_t)layer * DFF * D; P.win = args.in[5] + (size_t)layer * D * INC;
            P.glu = args.in[15] + (size_t)layer * 512 * 1024; P.sb = args.in[16] + (size_t)layer * 512 * D; P.dil = args.in[17] + (size_t)layer * 256 * D; P.ssm = args.in[18] + (size_t)layer * 512 * D;
            P.dsa = args.in[19] + (size_t)layer * 512 * D; P.wout = args.in[20] + (size_t)layer * D * D; P.up2 = args.in[21] + (size_t)layer * D * NUP; P.dn2 = args.in[22] + (size_t)layer * DFF * D;
            weights_phase(F, P, WT);
            { SsmPtrs SP; SP.lam_re = args.in[7] + layer * 2048; SP.lam_im = args.in[8] + layer * 2048; SP.log_dt = args.in[9] + layer * 32; SP.b_re = args.in[10] + layer * 32768; SP.b_im = args.in[11] + layer * 32768;
              SP.c_re = args.in[12] + layer * 32768; SP.c_im = args.in[13] + layer * 32768; SP.dsk = args.in[14] + layer * 512; apow_phase(F, SP, ws + WS_SSMT); }
            if (layer == 0) cast_phase(F, args.in[0], XB);
            STAGE_END_T(0);
        }
        ++st;
        for (int s = 0; s < 3; ++s) {
            if (s != 1) {
                if (STAGE_IF) {
                    pg8::Gemm g{XB, WT + (s == 0 ? W_1U : W_2U), M, NUP, D}; pg8::StaticOrder S; S.init(M, NUP, F.G, (int)blockIdx.x, WGM_UP);
                    pg8::EpiPair<0> E{HB, DFF};
                    pg8::gemm_phase<pg8::EpiPair<0>, pg8::StaticOrder, true, true>(F.lds + RING_OFF, g, S, E, F.tid);
                    STAGE_END_T(1);
                }
                ++st;
            } else {
                for (int c = 0; c < NCH; ++c) {
                    const size_t r0 = (size_t)c * MC;
                    if (STAGE_IF) {
                        pg8::Gemm g{XB + r0 * D, WT + W_IN, MC, NH, D}; pg8::StaticOrder S; S.init(MC, NH, F.G, (int)blockIdx.x, WGM_UP);
                        pg8::EpiH E{HB, HP, GATE_T0, GTL, VTS, VTD, VTA};
                        pg8::gemm_phase<pg8::EpiH, pg8::StaticOrder, true, true>(F.lds + RING_OFF, g, S, E, F.tid);
                        STAGE_END_T(2);
                    }
                    ++st;
                    if (STAGE_IF) {
                        {
                        __syncthreads();
                        PROBE_T0(0); ssm_mfma(F, HB, YG, args.in[14] + layer * 512, ws + WS_SSMT); PROBE_T1(0);
                        PROBE_T0(1); dsel_mfma(F, HB, (unsigned*)MASK, (LAS unsigned*)(F.lds + LDSCTL_OFF + 1024), F.lds + RING_OFF); PROBE_T1(1);
                        __syncthreads(); }
                        STAGE_END_T(3);
                    }
                    ++st;
                    if (STAGE_IF) {
                        __syncthreads();
                        { pg8::Gemm g{YG, WT + W_GLU, MC, 1024, 512}; pg8::StaticOrder S; S.init(MC, 1024, F.G, (int)blockIdx.x);
                          pg8::EpiPair<1> E{YSSM, 512};
                          pg8::gemm_phase<pg8::EpiPair<1>, pg8::StaticOrder, true, true>(F.lds + RING_OFF, g, S, E, F.tid); }
                        __syncthreads();
                        {
                        PROBE_T0(3); sb_mfma(F, HB, VTS, YSB); PROBE_T1(3);
                        PROBE_T0(4); dil_mfma(F, HB, VTD, YDIL, rel_bias, (LAS float*)(F.lds + LDSCTL_OFF + 9984)); PROBE_T1(4);
                        PROBE_T0(5); datt_mfma(F, HB, VTA, (const unsigned*)MASK, YDSA, rel_bias, (LAS float*)(F.lds + LDSCTL_OFF + 1024)); PROBE_T1(5);
                        }
                        STAGE_END_T(4);
                    }
                    ++st;
                    if (STAGE_IF) {
                        bf16* MGc = MG + r0 * D;
                        { pg8::Gemm g{YSB, WT + W_SB, MC, D, 512}; pg8::StaticOrder S; S.init(MC, D, F.G, (int)blockIdx.x); pg8::EpiGateAcc E{GTL, 0, MGc, D, 1};
                          pg8::gemm_phase<pg8::EpiGateAcc, pg8::StaticOrder, true, true>(F.lds + RING_OFF, g, S, E, F.tid); }
                        __syncthreads();
                        { pg8::Gemm g{YDIL, WT + W_DIL, MC, D, 256}; pg8::StaticOrder S; S.init(MC, D, F.G, (int)blockIdx.x); pg8::EpiGateAcc E{GTL, 1, MGc, D, 0};
                          pg8::gemm_phase<pg8::EpiGateAcc, pg8::StaticOrder, true, true>(F.lds + RING_OFF, g, S, E, F.tid); }
                        __syncthreads();
                        { pg8::Gemm g{YSSM, WT + W_SSM, MC, D, 512}; pg8::StaticOrder S; S.init(MC, D, F.G, (int)blockIdx.x); pg8::EpiGateAcc E{GTL, 2, MGc, D, 0};
                          pg8::gemm_phase<pg8::EpiGateAcc, pg8::StaticOrder, true, true>(F.lds + RING_OFF, g, S, E, F.tid); }
                        __syncthreads();
                        { pg8::Gemm g{YDSA, WT + W_DSA, MC, D, 512}; pg8::StaticOrder S; S.init(MC, D, F.G, (int)blockIdx.x); pg8::EpiGateAcc E{GTL, 3, MGc, D, 0};
                          pg8::gemm_phase<pg8::EpiGateAcc, pg8::StaticOrder, true, true>(F.lds + RING_OFF, g, S, E, F.tid); }
                        STAGE_END_T(5);
                    }
                    ++st;
                }
            }
            if (STAGE_IF) {
                const bf16* A = (s == 1) ? MG : HB; const bf16* Bt = WT + (s == 0 ? W_1D : (s == 1 ? W_OUT : W_2D)); const int K = (s == 1) ? D : DFF;
                pg8::Gemm g{A, Bt, M, D, K}; pg8::StaticOrder S; S.init(M, D, F.G, (int)blockIdx.x);
                const int first = (layer == 0 && s == 0), pidx = layer * 3 + s - 1;
                pg8::EpiResid E{first ? args.in[0] : X, X, (const pg8::f32x2e*)(ws + WS_STAT), args.in[1] + (size_t)(first ? 0 : pidx) * D, args.in[2] + (size_t)(first ? 0 : pidx) * D, D, first ? 0 : 1, DN_ALPHA, (s == 1) ? 1.0f : 0.5f};
                pg8::gemm_phase<pg8::EpiResid, pg8::StaticOrder, true, true>(F.lds + RING_OFF, g, S, E, F.tid);
                STAGE_END_T(s == 1 ? 7 : 6);
            }
            ++st;
            if (STAGE_IF) {
                ln_phase(F, X, args.in[1] + (size_t)(layer * 3 + s) * D, args.in[2] + (size_t)(layer * 3 + s) * D, XB, (f32x2v_*)(ws + WS_STAT), (layer == DEPTH - 1 && s == 2) ? 1 : 0);
                if (s == 0) { SsmPtrs SP; SP.lam_re = args.in[7] + layer * 2048; SP.lam_im = args.in[8] + layer * 2048; SP.log_dt = args.in[9] + layer * 32; SP.b_re = args.in[10] + layer * 32768; SP.b_im = args.in[11] + layer * 32768;
                  SP.c_re = args.in[12] + layer * 32768; SP.c_im = args.in[13] + layer * 32768; SP.dsk = args.in[14] + layer * 512; ssm_tables_phase(F, SP, ws + WS_SSMT); }
                STAGE_END_T(8);
            }
            ++st;
        }
    }
#undef STAGE_IF
#undef STAGE_END
#if MK_PROBE
    { unsigned long long* slot = (unsigned long long*)(ws + WS_CTL + 768 * 1024);
      stage_enter(F);
      if (F.tid == 0) __hip_atomic_store(slot + blockIdx.x, PR[1], __ATOMIC_RELAXED, __HIP_MEMORY_SCOPE_AGENT);
      xcd_barrier(bar);
      if (blockIdx.x == 0 && F.tid == 0) { unsigned long long sum = 0ull, mx = 0ull, mn = ~0ull;
          for (int i = PROBE_LO; i < PROBE_HI; ++i) { const unsigned long long v = __hip_atomic_load(slot + i, __ATOMIC_RELAXED, __HIP_MEMORY_SCOPE_AGENT); sum += v; mx = v > mx ? v : mx; mn = v < mn ? v : mn; }
          const unsigned long long q = (PROBE_KIND == 0) ? PR[1] : ((PROBE_KIND == 1) ? sum / (unsigned long long)(PROBE_HI - PROBE_LO) : (PROBE_KIND == 2 ? mx : mn));
          const unsigned long long t_end = __builtin_amdgcn_s_memrealtime() + q * PROBE_AMP;
          while (__builtin_amdgcn_s_memrealtime() < t_end) __builtin_amdgcn_s_sleep(8); } }
#endif
}
constexpr int N_STAGES = DEPTH * 17;

extern "C" void kernel_launch(void* const* d_in, const int* in_sizes, int n_in, void* d_out, int out_size, void* d_ws, size_t ws_size, hipStream_t stream) {
    static int grid = 0;
    if (grid == 0) {
        if (n_in != 23 || in_sizes[0] != M * D || out_size != M * D || ws_size < WS_END) { fprintf(stderr, "kernel_launch: unexpected shapes / workspace (n_in %d, in0 %d, out %d, ws %zu, need %zu)\n", n_in, n_in > 0 ? in_sizes[0] : -1, out_size, ws_size, (size_t)WS_END); grid = -1; return; }
        int dev = 0, cus = 0, per_cu = 0;
        if (hipGetDevice(&dev) != hipSuccess || hipDeviceGetAttribute(&cus, hipDeviceAttributeMultiprocessorCount, dev) != hipSuccess) { grid = -1; return; }
        if (hipFuncSetAttribute((const void*)fwd_kernel, hipFuncAttributeMaxDynamicSharedMemorySize, LDS_BYTES) != hipSuccess) { fprintf(stderr, "kernel_launch: hipFuncSetAttribute failed\n"); grid = -1; return; }
        if (hipOccupancyMaxActiveBlocksPerMultiprocessor(&per_cu, (const void*)fwd_kernel, NWAVES * 64, LDS_BYTES) != hipSuccess || per_cu < 1) fprintf(stderr, "kernel_launch: occupancy query says %d\n", per_cu);
        (void)hipGetLastError();
        grid = cus;
    }
    if (grid < 0) return;
    if (hipMemsetAsync((char*)d_ws + WS_CTL, 0, CTL_ZERO_BYTES, stream) != hipSuccess) return;
    Args a{};
    for (int i = 0; i < 23; ++i) a.in[i] = (const float*)d_in[i];
    a.out = (float*)d_out; a.ws = (unsigned char*)d_ws; a.pad = 0;
#if MK_ONE_LAUNCH
    a.lo = 0; a.hi = N_STAGES; a.use_bar = 1;
    hipLaunchKernelGGL(fwd_kernel, dim3(grid), dim3(NWAVES * 64), LDS_BYTES, stream, a);
#else
    for (int s = 0; s < N_STAGES; ++s) { a.lo = s; a.hi = s + 1; a.use_bar = 0; hipLaunchKernelGGL(fwd_kernel, dim3(grid), dim3(NWAVES * 64), LDS_BYTES, stream, a); }
#endif
}
```

```cpp
#include <hip/hip_runtime.h>
#include <cstdio>
#include <cstdint>
namespace pg8 {
#define PG8_LAS __attribute__((address_space(3)))
typedef unsigned short bf16_t;
typedef short bf16x8 __attribute__((ext_vector_type(8)));
typedef float f32x4 __attribute__((ext_vector_type(4)));
typedef unsigned u32x4 __attribute__((ext_vector_type(4)));
constexpr int BM = 256, BK = 64, HALF = 128, HTB = HALF * BK * 2  , STAGE_BYTES = 8 * HTB, NXCD = 8, WGM = 4;

__host__ __device__ __forceinline__ int lds_byte(int r, int c) { const int st = (r >> 4) * 2 + (c >> 5), rr = r & 15, cc = c & 31, ob = rr * 64 + cc * 2; return st * 1024 + (ob ^ (((ob >> 9) & 1) << 5)); }
__host__ __device__ __forceinline__ void stage_rc(int b, int& R, int& C) { const int st = b / 1024, sb = b % 1024, swz = sb ^ (((sb >> 9) & 1) << 5); R = (st >> 1) * 16 + swz / 64; C = (st & 1) * 32 + (swz % 64) / 2; }
__host__ __device__ __forceinline__ int perm32(int rho) { const int n = rho >> 4, i = rho & 15; return 8 * (i >> 2) + 4 * n + (i & 3); }

struct Unit { int pm, pn; };
struct Gemm { const bf16_t* A; const bf16_t* Bt; int M, N, K; };

struct StaticOrder {
    int nM, nN, nwg, G, c, wgm;
    __host__ __device__ void init(int M, int N, int G_, int c_, int wgm_ = WGM) { nM = M / BM; nN = N / BM; nwg = nM * nN; G = G_; c = c_; wgm = wgm_; }
    __host__ __device__ bool next(int i, Unit& u) const {
        const long L = (long)i * G + c; if (L >= nwg) return false;
        int wgid = (int)L; { const int q = nwg / NXCD, r = nwg % NXCD, xcd = wgid % NXCD, off = wgid / NXCD; wgid = (xcd < r ? xcd * (q + 1) : r * (q + 1) + (xcd - r) * q) + off; }
        const int nig = wgm * nN, gid = wgid / nig, fm = gid * wgm, gsz = (nM - fm) < wgm ? (nM - fm) : wgm;
        u.pm = fm + ((wgid % nig) % gsz); u.pn = (wgid % nig) / gsz; return true;
    }
    __device__ __forceinline__ void a_ready(const Unit&) const {}
    __device__ __forceinline__ void done(const Unit&) const {}
};

__device__ __forceinline__ unsigned cvt_pk_bf16(float lo, float hi) { unsigned r; asm volatile("v_cvt_pk_bf16_f32 %0, %1, %2" : "=v"(r) : "v"(lo), "v"(hi)); return r; }
typedef float f32x2 __attribute__((ext_vector_type(2)));
__device__ __forceinline__ float sigmoid_f(float a) { return __builtin_amdgcn_rcpf(1.0f + __builtin_amdgcn_exp2f(-1.4426950408889634f * a)); }
__device__ __forceinline__ float bf_lo(unsigned w) { return __uint_as_float(w << 16); }
__device__ __forceinline__ float bf_hi(unsigned w) { return __uint_as_float(w & 0xffff0000u); }
typedef float f32x2e __attribute__((ext_vector_type(2)));
template <int MODE> struct EpiPair {
    static constexpr bool PERM = true, AFTER_DRAIN = false;
    bf16_t* O; int ldo;
    __device__ __forceinline__ void operator()(f32x4 (&acc)[2][2][4][2], const Unit& u, int wr, int wc, int fr, int fq) const {
        const int row0 = u.pm * BM + wr * 64 + fr, col0 = u.pn * HALF + wc * 32 + 8 * fq;
#pragma unroll
        for (int ai = 0; ai < 2; ++ai)
#pragma unroll
            for (int m = 0; m < 4; ++m) { bf16_t* rowp = O + (size_t)(row0 + ai * HALF + m * 16) * ldo + col0;
                float r[8];
#pragma unroll
                for (int n = 0; n < 2; ++n) { const f32x4 av = acc[ai][0][m][n], bv = acc[ai][1][m][n];
#pragma unroll
                    for (int i = 0; i < 4; ++i) { const float a = av[i], b = bv[i];
                        r[n * 4 + i] = (MODE == 0) ? a * sigmoid_f(a) * b : a * sigmoid_f(b); } }
                u32x4 w; w.x = cvt_pk_bf16(r[0], r[1]); w.y = cvt_pk_bf16(r[2], r[3]); w.z = cvt_pk_bf16(r[4], r[5]); w.w = cvt_pk_bf16(r[6], r[7]);
                *(u32x4*)rowp = w;
                if (m & 1) __builtin_amdgcn_sched_barrier(0); }
    }
};
struct EpiH {
    static constexpr bool PERM = true, AFTER_DRAIN = false;
    bf16_t* O; int ldo; int gate_tile0; bf16_t* gt; bf16_t* vts; bf16_t* vtd; bf16_t* vta;
    __device__ __forceinline__ void store_vt(f32x4 (&acc)[2][2][4][2], const Unit& u, int wr, int wc, int fr, int fq) const {
        bf16_t* vb; int nh, h0, lay = 0;
        if (u.pn < 6) { vb = vts; nh = 8; h0 = (u.pn - 4) * 4; } else if (u.pn < 15) { vb = vtd; nh = 12; h0 = (u.pn - 12) * 4; lay = u.pn - 12; } else { vb = vta; nh = 8; h0 = (u.pn - 21) * 4; }
        const int r0 = u.pm * BM + wr * 64 + fr, bl = r0 >> 11, t0 = r0 & 2047;
        const int pos0 = lay == 0 ? t0 : (lay == 1 ? (t0 & 3) * 512 + (t0 >> 2) : (t0 & 15) * 128 + (t0 >> 4));
        const int step_m = lay == 0 ? 16 : (lay == 1 ? 4 : 1), step_ai = 8 * step_m;
        bf16_t* p0 = vb + ((size_t)(bl * nh + h0 + (wc >> 1)) * 64 + 32 * (wc & 1) + 8 * fq) * 2048 + pos0;
#pragma unroll
        for (int ai = 0; ai < 2; ++ai)
#pragma unroll
            for (int m = 0; m < 4; ++m)
#pragma unroll
                for (int bj = 0; bj < 2; ++bj) { bf16_t* p = p0 + (size_t)bj * (2 * 64 * 2048) + ai * step_ai + m * step_m;
#pragma unroll
                    for (int n = 0; n < 2; ++n)
#pragma unroll
                        for (int i = 0; i < 4; i += 2) { const unsigned w = cvt_pk_bf16(acc[ai][bj][m][n][i], acc[ai][bj][m][n][i + 1]);
                            p[(size_t)(4 * n + i) * 2048] = (bf16_t)(w & 0xffffu); p[(size_t)(4 * n + i + 1) * 2048] = (bf16_t)(w >> 16); } }
    }
    __device__ __forceinline__ void operator()(f32x4 (&acc)[2][2][4][2], const Unit& u, int wr, int wc, int fr_in, int fq) const {
        int fr = fr_in; asm volatile("" : "+v"(fr));
        if (u.pn == 4 || u.pn == 5 || (u.pn >= 12 && u.pn <= 14) || u.pn == 21 || u.pn == 22) { store_vt(acc, u, wr, wc, fr, fq); return; }
        const int row0 = u.pm * BM + wr * 64 + fr, col0 = u.pn * BM + wc * 32 + 8 * fq; const bool sg = u.pn >= gate_tile0;
#pragma unroll
        for (int ai = 0; ai < 2; ++ai)
#pragma unroll
            for (int m = 0; m < 4; ++m) { bf16_t* rowp = O + (size_t)(row0 + ai * HALF + m * 16) * ldo + col0;
                if (sg) { const int gp = u.pn - gate_tile0;
                    rowp = gt + ((size_t)(u.pm * 4 + (gp >> 3)) * 8 + (gp & 7)) * 65536 + (size_t)(wr * 64 + fr + ai * HALF + m * 16) * 256 + wc * 32 + 8 * fq; }
#pragma unroll
                for (int bj = 0; bj < 2; ++bj) { f32x4 v0 = acc[ai][bj][m][0], v1 = acc[ai][bj][m][1];
                    if (sg) {
#pragma unroll
                        for (int i = 0; i < 4; ++i) { v0[i] = sigmoid_f(v0[i]); v1[i] = sigmoid_f(v1[i]); } }
                    u32x4 w; w.x = cvt_pk_bf16(v0[0], v0[1]); w.y = cvt_pk_bf16(v0[2], v0[3]); w.z = cvt_pk_bf16(v1[0], v1[1]); w.w = cvt_pk_bf16(v1[2], v1[3]);
                    *(u32x4*)(rowp + bj * HALF) = w; }
                if (m & 1) __builtin_amdgcn_sched_barrier(0); }
    }
};
struct EpiResid {
    static constexpr bool PERM = false, AFTER_DRAIN = false;
    const float* base; float* out; const f32x2e* stat; const float* g; const float* b; int ldc, nrm; float alpha, sc;
    __device__ __forceinline__ void operator()(f32x4 (&acc)[2][2][4][2], const Unit& u, int wr, int wc, int fr, int fq) const {
        const int col0 = u.pn * BM + wc * 32 + 4 * fq, row0 = u.pm * BM + wr * 64 + fr;
        f32x4 gg[2][2], bb[2][2];
#pragma unroll
        for (int bj = 0; bj < 2; ++bj)
#pragma unroll
            for (int n = 0; n < 2; ++n) { gg[bj][n] = (f32x4){1.f, 1.f, 1.f, 1.f}; bb[bj][n] = (f32x4){0.f, 0.f, 0.f, 0.f};
                if (nrm) { gg[bj][n] = *(const f32x4*)(g + col0 + bj * HALF + n * 16); bb[bj][n] = *(const f32x4*)(b + col0 + bj * HALF + n * 16); } }
        f32x2e stq[2]; stq[0] = nrm ? stat[row0] : (f32x2e){0.f, 1.f};
        f32x4 yq[2][2][2];
#pragma unroll
        for (int bj = 0; bj < 2; ++bj)
#pragma unroll
            for (int n = 0; n < 2; ++n) yq[0][bj][n] = *(const f32x4*)(base + (size_t)row0 * ldc + col0 + bj * HALF + n * 16);
#pragma unroll
        for (int k = 0; k < 8; ++k) { const int ai = k >> 2, m = k & 3; const int row = row0 + ai * HALF + m * 16; const size_t off = (size_t)row * ldc + col0;
            if (k < 7) { const int rn = row0 + ((k + 1) >> 2) * HALF + ((k + 1) & 3) * 16; stq[(k + 1) & 1] = nrm ? stat[rn] : (f32x2e){0.f, 1.f};
#pragma unroll
                for (int bj = 0; bj < 2; ++bj)
#pragma unroll
                    for (int n = 0; n < 2; ++n) yq[(k + 1) & 1][bj][n] = *(const f32x4*)(base + (size_t)rn * ldc + col0 + bj * HALF + n * 16); }
            const f32x2e st = stq[k & 1];
#pragma unroll
            for (int bj = 0; bj < 2; ++bj)
#pragma unroll
                for (int n = 0; n < 2; ++n) { const size_t o2 = off + bj * HALF + n * 16;
                    const f32x4 xp = (yq[k & 1][bj][n] - st.x) * st.y * gg[bj][n] + bb[bj][n];
                    const f32x4 y = xp * alpha + acc[ai][bj][m][n] * sc;
                    *(f32x4*)(out + o2) = y; }
            __builtin_amdgcn_sched_barrier(0); }
    }
};
struct EpiResidB {
    static constexpr bool PERM = false, AFTER_DRAIN = false;
    const bf16_t* xb; float* out; int ldc; float alpha, sc;
    __device__ __forceinline__ void operator()(f32x4 (&acc)[2][2][4][2], const Unit& u, int wr, int wc, int fr_in, int fq) const {
        int fr = fr_in; asm volatile("" : "+v"(fr));
        const int col0 = u.pn * BM + wc * 32 + 4 * fq, row0 = u.pm * BM + wr * 64 + fr;
        unsigned long long xq[2][2][2];
#pragma unroll
        for (int bj = 0; bj < 2; ++bj)
#pragma unroll
            for (int n = 0; n < 2; ++n) xq[0][bj][n] = *(const unsigned long long*)(xb + (size_t)row0 * ldc + col0 + bj * HALF + n * 16);
#pragma unroll
        for (int k = 0; k < 8; ++k) { const int ai = k >> 2, m = k & 3; const int row = row0 + ai * HALF + m * 16; const size_t off = (size_t)row * ldc + col0;
            if (k < 7) { const int rn = row0 + ((k + 1) >> 2) * HALF + ((k + 1) & 3) * 16;
#pragma unroll
                for (int bj = 0; bj < 2; ++bj)
#pragma unroll
                    for (int n = 0; n < 2; ++n) xq[(k + 1) & 1][bj][n] = *(const unsigned long long*)(xb + (size_t)rn * ldc + col0 + bj * HALF + n * 16); }
#pragma unroll
            for (int bj = 0; bj < 2; ++bj)
#pragma unroll
                for (int n = 0; n < 2; ++n) { const size_t o2 = off + bj * HALF + n * 16; const unsigned long long v = xq[k & 1][bj][n]; const unsigned lo = (unsigned)v, hi = (unsigned)(v >> 32);
                    const f32x4 xp = (f32x4){bf_lo(lo), bf_hi(lo), bf_lo(hi), bf_hi(hi)};
                    const f32x4 y = xp * alpha + acc[ai][bj][m][n] * sc;
                    *(f32x4*)(out + o2) = y; }
            __builtin_amdgcn_sched_barrier(0); }
    }
};
struct EpiResidC {
    static constexpr bool PERM = true, AFTER_DRAIN = false;
    const bf16_t* xb; bf16_t* yb; int ldc; float alpha, sc;
    __device__ __forceinline__ void operator()(f32x4 (&acc)[2][2][4][2], const Unit& u, int wr, int wc, int fr_in, int fq) const {
        int fr = fr_in; asm volatile("" : "+v"(fr));
        const int row0 = u.pm * BM + wr * 64 + fr, col0 = u.pn * BM + wc * 32 + 8 * fq;
        u32x4 xq[2][2];
#pragma unroll
        for (int bj = 0; bj < 2; ++bj) xq[0][bj] = *(const u32x4*)(xb + (size_t)row0 * ldc + col0 + bj * HALF);
#pragma unroll
        for (int k = 0; k < 8; ++k) { const int ai = k >> 2, m = k & 3; const size_t off = (size_t)(row0 + ai * HALF + m * 16) * ldc + col0;
            if (k < 7) { const int rn = row0 + ((k + 1) >> 2) * HALF + ((k + 1) & 3) * 16;
#pragma unroll
                for (int bj = 0; bj < 2; ++bj) xq[(k + 1) & 1][bj] = *(const u32x4*)(xb + (size_t)rn * ldc + col0 + bj * HALF); }
#pragma unroll
            for (int bj = 0; bj < 2; ++bj) { const u32x4 x = xq[k & 1][bj]; const f32x4 v0 = acc[ai][bj][m][0], v1 = acc[ai][bj][m][1];
                u32x4 w;
                w.x = cvt_pk_bf16(bf_lo(x.x) * alpha + v0[0] * sc, bf_hi(x.x) * alpha + v0[1] * sc);
                w.y = cvt_pk_bf16(bf_lo(x.y) * alpha + v0[2] * sc, bf_hi(x.y) * alpha + v0[3] * sc);
                w.z = cvt_pk_bf16(bf_lo(x.z) * alpha + v1[0] * sc, bf_hi(x.z) * alpha + v1[1] * sc);
                w.w = cvt_pk_bf16(bf_lo(x.w) * alpha + v1[2] * sc, bf_hi(x.w) * alpha + v1[3] * sc);
                *(u32x4*)(yb + off + bj * HALF) = w; }
            __builtin_amdgcn_sched_barrier(0); }
    }
};
struct EpiGateAcc {
    static constexpr bool PERM = true, AFTER_DRAIN = false;
    const bf16_t* G; int branch; bf16_t* O; int ldo; int first;
    __device__ __forceinline__ void operator()(f32x4 (&acc)[2][2][4][2], const Unit& u, int wr, int wc, int fr, int fq) const {
        const int row0 = u.pm * BM + wr * 64 + fr, col0 = u.pn * BM + wc * 32 + 8 * fq;
#pragma unroll
        for (int ai = 0; ai < 2; ++ai) {
            u32x4 gw[4][2], pw[4][2];
#pragma unroll
            for (int m = 0; m < 4; ++m)
#pragma unroll
                for (int bj = 0; bj < 2; ++bj) { const int row = row0 + ai * HALF + m * 16;
                    gw[m][bj] = *(const u32x4*)(G + ((size_t)(u.pm * 4 + branch) * 8 + u.pn) * 65536 + (size_t)(row - u.pm * BM) * 256 + wc * 32 + 8 * fq + bj * HALF);
                    pw[m][bj] = (u32x4){0u, 0u, 0u, 0u}; if (!first) pw[m][bj] = *(const u32x4*)(O + (size_t)row * ldo + col0 + bj * HALF); }
#pragma unroll
            for (int m = 0; m < 4; ++m)
#pragma unroll
                for (int bj = 0; bj < 2; ++bj) { const int row = row0 + ai * HALF + m * 16; bf16_t* op = O + (size_t)row * ldo + col0 + bj * HALF;
                    const f32x4 v0 = acc[ai][bj][m][0], v1 = acc[ai][bj][m][1]; const u32x4 g = gw[m][bj], p = pw[m][bj];
                    u32x4 w;
                    w.x = cvt_pk_bf16(bf_lo(p.x) + bf_lo(g.x) * v0[0], bf_hi(p.x) + bf_hi(g.x) * v0[1]);
                    w.y = cvt_pk_bf16(bf_lo(p.y) + bf_lo(g.y) * v0[2], bf_hi(p.y) + bf_hi(g.y) * v0[3]);
                    w.z = cvt_pk_bf16(bf_lo(p.z) + bf_lo(g.z) * v1[0], bf_hi(p.z) + bf_hi(g.z) * v1[1]);
                    w.w = cvt_pk_bf16(bf_lo(p.w) + bf_lo(g.w) * v1[2], bf_hi(p.w) + bf_hi(g.w) * v1[3]);
                    *(u32x4*)op = w; }
        }
    }
};
template <class Epi, class Sched, bool ALIGN_EPI = false, bool SP2 = false>
__device__ __forceinline__ void gemm_phase(PG8_LAS unsigned char* lds, const Gemm g, const Sched& S, const Epi& E, int tid_in) {
    int tid_ = tid_in; asm volatile("" : "+v"(tid_));
    const int tid = tid_, wid = __builtin_amdgcn_readfirstlane(tid >> 6), lane = tid & 63, wr = wid >> 2, wc = wid & 3, fr = lane & 15, fq = lane >> 4;
    const int K = g.K, nt = K / BK;
    unsigned voffA[2], voffB[2];
#pragma unroll
    for (int i = 0; i < 2; ++i) { int R, C; stage_rc(tid * 16 + i * 8192, R, C); const int Rb = Epi::PERM ? ((R & ~31) + perm32(R & 31)) : R;
        voffA[i] = (unsigned)(R * K + C) * 2u; voffB[i] = (unsigned)(Rb * K + C) * 2u; }
    const size_t kstep = (size_t)(BK * 2);
    const size_t hstep = (size_t)HALF * K * 2;
    const size_t tstep = 2 * hstep;
    const unsigned ldsw = (unsigned)wid * 1024u;
    const int aoff = lds_byte(wr * 64 + fr, fq * 8), boff = lds_byte(wc * 32 + fr, fq * 8);
#define PG8_SA(b, h) (((b) * 2 + (h)) * HTB)
#define PG8_SB(b, h) ((4 + (b) * 2 + (h)) * HTB)
#define PG8_STAGE(bufoff, gbase, voff) do { _Pragma("unroll") for (int _i = 0; _i < 2; ++_i) \
        __builtin_amdgcn_global_load_lds((const unsigned*)((const char*)(gbase) + (voff)[_i]), (PG8_LAS unsigned*)(lds + (bufoff) + ldsw + _i * 8192), 16, 0, 0); } while (0)
#define PG8_LDA(dst, b, h) do { _Pragma("unroll") for (int m = 0; m < 4; ++m) _Pragma("unroll") for (int k = 0; k < 2; ++k) dst[m][k] = *(const PG8_LAS bf16x8*)(lds + PG8_SA(b, h) + aoff + m * 2048 + k * 1024); } while (0)
#define PG8_LDB(dst, b, h) do { _Pragma("unroll") for (int n = 0; n < 2; ++n) _Pragma("unroll") for (int k = 0; k < 2; ++k) dst[n][k] = *(const PG8_LAS bf16x8*)(lds + PG8_SB(b, h) + boff + n * 2048 + k * 1024); } while (0)
#define PG8_MMA(ai, bj, At, Bt) do { __builtin_amdgcn_s_setprio(1); _Pragma("unroll") for (int m = 0; m < 4; ++m) _Pragma("unroll") for (int n = 0; n < 2; ++n) _Pragma("unroll") for (int k = 0; k < 2; ++k) \
        acc[ai][bj][m][n] = __builtin_amdgcn_mfma_f32_16x16x32_bf16(Bt[n][k], At[m][k], acc[ai][bj][m][n], 0, 0, 0); __builtin_amdgcn_s_setprio(0); } while (0)
#define PG8_WAIT_V(n) asm volatile("s_waitcnt vmcnt(" #n ")" ::: "memory")
#define PG8_WAIT_L(n) asm volatile("s_waitcnt lgkmcnt(" #n ")" ::: "memory")
#define PG8_BAR __builtin_amdgcn_s_barrier()
#define PG8_SCHED __builtin_amdgcn_sched_barrier(0)
    Unit cur, nxt; int ui = 0;
    if (!S.next(0, cur)) return;
    f32x4 acc[2][2][4][2];
#pragma unroll
    for (int a = 0; a < 2; ++a)
#pragma unroll
        for (int b = 0; b < 2; ++b)
#pragma unroll
            for (int m = 0; m < 4; ++m)
#pragma unroll
                for (int n = 0; n < 2; ++n) acc[a][b][m][n] = (f32x4){0.f, 0.f, 0.f, 0.f};
    bf16x8 At[4][2], B0[2][2], B1[2][2];
    const char* cA = (const char*)g.A + (size_t)cur.pm * tstep; const char* cB = (const char*)g.Bt + (size_t)cur.pn * tstep;
    S.a_ready(cur);
    if constexpr (SP2) {
        PG8_STAGE(PG8_SB(0, 0), cB, voffB); PG8_STAGE(PG8_SB(0, 1), cB + hstep, voffB); PG8_STAGE(PG8_SA(0, 0), cA, voffA); PG8_STAGE(PG8_SA(0, 1), cA + hstep, voffA);
        if (wr == 1) PG8_BAR;
        PG8_WAIT_V(2); PG8_BAR;
        PG8_STAGE(PG8_SB(1, 0), cB + kstep, voffB); PG8_STAGE(PG8_SA(1, 0), cA + kstep, voffA); PG8_STAGE(PG8_SB(1, 1), cB + hstep + kstep, voffB);
        PG8_WAIT_V(6); PG8_BAR;
    } else {
        PG8_STAGE(PG8_SB(0, 0), cB, voffB); PG8_STAGE(PG8_SA(0, 0), cA, voffA); PG8_STAGE(PG8_SB(0, 1), cB + hstep, voffB); PG8_STAGE(PG8_SA(0, 1), cA + hstep, voffA);
        if (wr == 1) PG8_BAR;
        PG8_WAIT_V(4); PG8_BAR;
        PG8_STAGE(PG8_SB(1, 0), cB + kstep, voffB); PG8_STAGE(PG8_SA(1, 0), cA + kstep, voffA); PG8_STAGE(PG8_SB(1, 1), cB + hstep + kstep, voffB);
        PG8_WAIT_V(6); PG8_BAR;
    }
    for (;;) {
        const bool has_next = S.next(ui + 1, nxt);
        const char* nA = has_next ? (const char*)g.A + (size_t)nxt.pm * tstep : cA; const char* nB = has_next ? (const char*)g.Bt + (size_t)nxt.pn * tstep : cB;
        for (int t = 0; t < nt; t += 2) {
            const bool last = (t == nt - 2);
            const char* a1 = cA + (size_t)(t + 1) * kstep;
            const char* a2 = last ? nA : cA + (size_t)(t + 2) * kstep; const char* b2 = last ? nB : cB + (size_t)(t + 2) * kstep;
            const char* a3 = a2 + kstep; const char* b3 = b2 + kstep;
            if (last && has_next) S.a_ready(nxt);
            if constexpr (SP2) {
            PG8_LDB(B0, 0, 0); PG8_LDB(B1, 0, 1); PG8_SCHED; PG8_LDA(At, 0, 0); PG8_STAGE(PG8_SA(1, 1), a1 + hstep, voffA);
            PG8_WAIT_V(8); PG8_WAIT_L(0); PG8_BAR; PG8_MMA(0, 0, At, B0); PG8_MMA(0, 1, At, B1); PG8_BAR; PG8_SCHED;
            PG8_LDA(At, 0, 1); PG8_STAGE(PG8_SB(0, 0), b2, voffB); PG8_STAGE(PG8_SB(0, 1), b2 + hstep, voffB); PG8_STAGE(PG8_SA(0, 0), a2, voffA);
            PG8_WAIT_V(8); PG8_WAIT_L(0); PG8_BAR; PG8_MMA(1, 0, At, B0); PG8_MMA(1, 1, At, B1); PG8_BAR; PG8_SCHED;
            PG8_LDB(B0, 1, 0); PG8_LDB(B1, 1, 1); PG8_SCHED; PG8_LDA(At, 1, 0); PG8_STAGE(PG8_SA(0, 1), a2 + hstep, voffA);
            PG8_WAIT_V(8); PG8_WAIT_L(0); PG8_BAR; PG8_MMA(0, 0, At, B0); PG8_MMA(0, 1, At, B1); PG8_BAR; PG8_SCHED;
            PG8_LDA(At, 1, 1); PG8_STAGE(PG8_SB(1, 0), b3, voffB); PG8_STAGE(PG8_SB(1, 1), b3 + hstep, voffB); PG8_STAGE(PG8_SA(1, 0), a3, voffA);
            PG8_WAIT_V(8); PG8_WAIT_L(0); PG8_BAR; PG8_MMA(1, 0, At, B0); PG8_MMA(1, 1, At, B1); PG8_BAR; PG8_SCHED;
            } else {
            PG8_LDB(B0, 0, 0); PG8_SCHED; PG8_LDA(At, 0, 0); PG8_STAGE(PG8_SA(1, 1), a1 + hstep, voffA);
            PG8_WAIT_L(8); PG8_BAR; PG8_WAIT_L(0); PG8_MMA(0, 0, At, B0); PG8_BAR; PG8_SCHED;
            PG8_LDB(B1, 0, 1); PG8_STAGE(PG8_SB(0, 0), b2, voffB);
            PG8_BAR; PG8_WAIT_L(0); PG8_MMA(0, 1, At, B1); PG8_BAR;
            PG8_LDA(At, 0, 1); PG8_STAGE(PG8_SA(0, 0), a2, voffA);
            PG8_BAR; PG8_WAIT_L(0); PG8_MMA(1, 0, At, B0); PG8_BAR; PG8_SCHED;
            PG8_STAGE(PG8_SB(0, 1), b2 + hstep, voffB);
            PG8_WAIT_V(6); PG8_BAR; PG8_MMA(1, 1, At, B1); PG8_BAR;
            PG8_LDB(B0, 1, 0); PG8_SCHED; PG8_LDA(At, 1, 0); PG8_STAGE(PG8_SA(0, 1), a2 + hstep, voffA);
            PG8_WAIT_L(8); PG8_BAR; PG8_WAIT_L(0); PG8_MMA(0, 0, At, B0); PG8_BAR; PG8_SCHED;
            PG8_LDB(B1, 1, 1); PG8_STAGE(PG8_SB(1, 0), b3, voffB);
            PG8_BAR; PG8_WAIT_L(0); PG8_MMA(0, 1, At, B1); PG8_BAR;
            PG8_LDA(At, 1, 1); PG8_STAGE(PG8_SA(1, 0), a3, voffA);
            PG8_BAR; PG8_WAIT_L(0); PG8_MMA(1, 0, At, B0); PG8_BAR; PG8_SCHED;
            PG8_STAGE(PG8_SB(1, 1), b3 + hstep, voffB);
            PG8_WAIT_V(6); PG8_BAR; PG8_MMA(1, 1, At, B1); PG8_BAR;
            }
        }
        if constexpr (ALIGN_EPI) { if (wr == 0) PG8_BAR; }
        if constexpr (!Epi::AFTER_DRAIN) { E(acc, cur, wr, wc, fr, fq); S.done(cur); }
        if (!has_next) break;
#pragma unroll
        for (int a = 0; a < 2; ++a)
#pragma unroll
            for (int b = 0; b < 2; ++b)
#pragma unroll
                for (int m = 0; m < 4; ++m)
#pragma unroll
                    for (int n = 0; n < 2; ++n) acc[a][b][m][n] = (f32x4){0.f, 0.f, 0.f, 0.f};
        cur = nxt; cA = nA; cB = nB; ++ui;
        if constexpr (ALIGN_EPI) { if (wr == 1) PG8_BAR; }
    }
    PG8_WAIT_V(0);
    if constexpr (!ALIGN_EPI) { if (wr == 0) PG8_BAR; }
    PG8_BAR;
    if constexpr (Epi::AFTER_DRAIN) { E.fused(acc, cur, wr, wc, fr, fq, lds, wid, lane); S.done(cur); }
#undef PG8_SA
#undef PG8_SB
#undef PG8_STAGE
#undef PG8_LDA
#undef PG8_LDB
#undef PG8_MMA
#undef PG8_WAIT_V
#undef PG8_WAIT_L
#undef PG8_BAR
#undef PG8_SCHED
}
}

constexpr int NWAVES = 8;
#ifndef WGM_UP
#define WGM_UP 8
#endif
#ifndef MK_ONE_LAUNCH
#define MK_ONE_LAUNCH 1
#endif
constexpr int BATCH = 16, SEQ = 2048, D = 2048, M = BATCH * SEQ, DFF = 5632, NUP = 2 * DFF, DEPTH = 2;
constexpr int INC = 14664, NH = 14848, HP = 6656, GATE_T0 = 26;
constexpr int NCH = 2, MC = M / NCH, BC = BATCH / NCH;
constexpr int C_SBQ = 0, C_SBK = 512, C_SBV = 1024, C_DQ = 1536, C_DK = 2304, C_DV = 3072, C_U = 3840, C_AQ = 4352, C_AK = 4864, C_AV = 5376, C_IQ = 5888, C_IK = 6400, C_IW = 6464, C_GATE = 6656;
constexpr float LOG2E = 1.4426950408889634f, QSC = 0.125f * 1.4426950408889634f, DN_ALPHA = 1.4142135623730951f, LN_EPS = 1e-5f;
constexpr size_t MiB = 1u << 20;
constexpr size_t WS_CTL = 0, CTL_ZERO_BYTES = 1 * MiB;
constexpr size_t WS_WT = 1 * MiB;
constexpr size_t W_1U = 0, W_1D = W_1U + (size_t)NUP * D, W_IN = W_1D + (size_t)D * DFF, W_GLU = W_IN + (size_t)NH * D, W_SB = W_GLU + 1024 * 512, W_DIL = W_SB + 2048 * 512,
                 W_SSM = W_DIL + 2048 * 256, W_DSA = W_SSM + 2048 * 512, W_OUT = W_DSA + 2048 * 512, W_2U = W_OUT + (size_t)D * D, W_2D = W_2U + (size_t)NUP * D, W_END = W_2D + (size_t)D * DFF;
static_assert(W_END * 2 <= 207 * MiB, "weights region");
constexpr size_t WS_XB = 208 * MiB;
constexpr size_t WS_MG = 336 * MiB;
constexpr size_t WS_H = 464 * MiB, WS_GT = WS_H + 208 * MiB;
constexpr size_t WS_YSB = 928 * MiB, WS_YDIL = 944 * MiB, WS_YSSM = 952 * MiB, WS_YDSA = 968 * MiB, WS_YG = 984 * MiB, WS_MASK = 1000 * MiB, WS_VTS = 1004 * MiB, WS_VTD = 1020 * MiB, WS_VTA = 1044 * MiB, WS_SSMT = 1060 * MiB, WS_END = 1070 * MiB;
static_assert((size_t)MC * HP * 2 <= 208 * MiB && (size_t)(MC / 256) * 32 * 65536 * 2 <= 256 * MiB && (size_t)M * DFF * 2 <= 464 * MiB, "h region");
constexpr size_t WS_STAT = WS_CTL + 512 * 1024;
constexpr int CW_BAR = 4096;
constexpr int RING_OFF = 0, RING_BYTES = 131072, LDSCTL_OFF = RING_BYTES, MISC_OFF = LDSCTL_OFF + 320, LDS_BYTES = 147456;

#define GAS __attribute__((address_space(1)))
#define LAS __attribute__((address_space(3)))
typedef unsigned short bf16;
typedef unsigned v4u __attribute__((ext_vector_type(4)));
typedef float f32x4 __attribute__((ext_vector_type(4)));
typedef GAS unsigned gu32;
typedef float f32x2v_ __attribute__((ext_vector_type(2)));
#define RLX_AGENT __ATOMIC_RELAXED, __HIP_MEMORY_SCOPE_AGENT
#define LDS_WAIT() asm volatile("s_waitcnt lgkmcnt(0)" ::: "memory")
#define VM_WAIT() asm volatile("s_waitcnt vmcnt(0)" ::: "memory")
__device__ __forceinline__ unsigned f2bf(float f) { unsigned u = __builtin_bit_cast(unsigned, f); return (u + 0x7fffu + ((u >> 16) & 1u)) >> 16; }
__device__ __forceinline__ unsigned pk2(float lo, float hi) { return f2bf(lo) | (f2bf(hi) << 16); }
__device__ __forceinline__ float bflo(unsigned w) { return __uint_as_float(w << 16); }
__device__ __forceinline__ float bfhi(unsigned w) { return __uint_as_float(w & 0xffff0000u); }
__device__ __forceinline__ void ld8(const bf16* p, float* f) { const v4u w = *(const GAS v4u*)p; f[0] = bflo(w.x); f[1] = bfhi(w.x); f[2] = bflo(w.y); f[3] = bfhi(w.y); f[4] = bflo(w.z); f[5] = bfhi(w.z); f[6] = bflo(w.w); f[7] = bfhi(w.w); }
__device__ __forceinline__ void st8(bf16* p, const float* f) { v4u w; w.x = pk2(f[0], f[1]); w.y = pk2(f[2], f[3]); w.z = pk2(f[4], f[5]); w.w = pk2(f[6], f[7]); *(GAS v4u*)p = w; }
__device__ __forceinline__ float ex2(float x) { return __builtin_amdgcn_exp2f(x); }
__device__ __forceinline__ float lg2(float x) { return __builtin_amdgcn_logf(x); }
__device__ __forceinline__ float wave_sum(float v) {
#pragma unroll
    for (int o = 1; o < 64; o <<= 1) v += __shfl_xor(v, o);
    return v;
}
__device__ __forceinline__ int t5_bucket(int d) {
    if (d < 16) return d;
    return 15 + (d >= 16) + (d >= 19) + (d >= 21) + (d >= 24) + (d >= 27) + (d >= 31) + (d >= 35) + (d >= 40) + (d >= 46) + (d >= 52) + (d >= 59) + (d >= 67) + (d >= 77) + (d >= 87) + (d >= 99) + (d >= 113);
}

#define XB_TMO      128
#define XB_XCNT(j)  (256  + 64 * (j))
#define XB_XSUB(j)  (1280 + 64 * (j))
#define XB_XGEN(j)  (2304 + 64 * (j))
#define XB_TOP      3328
#define XB_TOPGEN   3392
#define XCD_BAR_WORDS 3456
#define XB_SPIN_CAP (1u << 18)

__device__ __forceinline__ unsigned xb_ld(unsigned* p)              { return __hip_atomic_load(p, __ATOMIC_RELAXED, __HIP_MEMORY_SCOPE_AGENT); }
__device__ __forceinline__ unsigned xb_add(unsigned* p, unsigned v) { return __hip_atomic_fetch_add(p, v, __ATOMIC_RELAXED, __HIP_MEMORY_SCOPE_AGENT); }
__device__ __forceinline__ unsigned xb_xcc_id() { return (unsigned)__builtin_amdgcn_s_getreg((3 << 11) | 20) & 0xFu; }
#define XB_SPIN(cond, bar) do { unsigned _sp = 0; while (cond) { __builtin_amdgcn_s_sleep(1); \
    if ((++_sp & 255u) == 0u) { if (xb_ld(&(bar)[XB_TMO])) break; if (_sp > XB_SPIN_CAP) { atomicAdd(&(bar)[XB_TMO], 1u); break; } } } } while (0)

struct XcdBarrier {
    unsigned* bar; unsigned x;
    volatile LAS unsigned* st;
};

__device__ __forceinline__ XcdBarrier xcd_barrier_post(unsigned* bar, volatile LAS unsigned* st) {
    XcdBarrier b; b.bar = bar; b.x = xb_xcc_id(); b.st = st;
    if (threadIdx.x == 0) (void)xb_add(&bar[XB_XCNT(b.x)], 1u);
    return b;
}
__device__ __forceinline__ void xcd_barrier_complete(unsigned* bar, unsigned x, unsigned& nloc, unsigned& nx) {
    const unsigned G = gridDim.x * gridDim.y * gridDim.z;
    unsigned sum, cnt, mine, sp = 0u;
    for (;;) {
        sum = 0u; cnt = 0u; mine = 0u;
#pragma unroll
        for (unsigned j = 0; j < 16; ++j) { const unsigned c = xb_ld(&bar[XB_XCNT(j)]); sum += c; cnt += (c > 0u) ? 1u : 0u; mine = (j == x) ? c : mine; }
        if (sum == G) break;
        __builtin_amdgcn_s_sleep(1);
        if ((++sp & 255u) == 0u) { if (xb_ld(&bar[XB_TMO])) break; if (sp > XB_SPIN_CAP) { atomicAdd(&bar[XB_TMO], 1u); break; } }
    }
    nloc = mine > 0u ? mine : 1u; nx = cnt > 0u ? cnt : 1u;
}

__device__ __forceinline__ void xcd_barrier(const XcdBarrier& b) {
    asm volatile("s_waitcnt vmcnt(0)" ::: "memory");
    __syncthreads();
    if (threadIdx.x == 0) {
        unsigned* bar = b.bar;
        __builtin_amdgcn_s_waitcnt(0);
        unsigned nloc = b.st[0], nx = b.st[1];
        if (nloc == 0u) { xcd_barrier_complete(bar, b.x, nloc, nx); b.st[0] = nloc; b.st[1] = nx; }
        const unsigned old = xb_add(&bar[XB_XSUB(b.x)], 1u);
        const unsigned gen = old / nloc;
        if (old + 1u == (gen + 1u) * nloc) {
            __builtin_amdgcn_fence(__ATOMIC_RELEASE, "agent");
            asm volatile("s_waitcnt vmcnt(0)" ::: "memory");
            const unsigned og = xb_add(&bar[XB_TOP], 1u);
            const unsigned tg = og / nx;
            if (og + 1u == (tg + 1u) * nx) xb_add(&bar[XB_TOPGEN], 1u);
            else XB_SPIN(xb_ld(&bar[XB_TOPGEN]) == tg, bar);
            __builtin_amdgcn_fence(__ATOMIC_ACQUIRE, "agent");
            xb_add(&bar[XB_XGEN(b.x)], 1u);
            asm volatile("s_waitcnt vmcnt(0)" ::: "memory");
        } else {
            XB_SPIN(xb_ld(&bar[XB_XGEN(b.x)]) == gen, bar);
            __builtin_amdgcn_fence(__ATOMIC_ACQUIRE, "agent");
            asm volatile("s_waitcnt vmcnt(0)" ::: "memory");
        }
    }
    __syncthreads();
}


struct Frame {
    LAS unsigned char* lds;
    int tid, lane, wave, G;
};

struct MapId { __device__ __forceinline__ void operator()(int np, int& src, float& sc) const { src = np; sc = 1.f; } };
struct MapPair { int half; __device__ __forceinline__ void operator()(int np, int& src, float& sc) const { const int pn = np >> 8, bj = (np >> 7) & 1, c = np & 127; src = bj * half + 128 * pn + c; sc = 1.f; } };
struct MapIn { __device__ __forceinline__ void operator()(int np, int& src, float& sc) const {
    if (np < 6472) { src = np; sc = (np < 512 || (np >= 1536 && np < 2304) || (np >= 4352 && np < 4864)) ? QSC : 1.f; }
    else if (np < C_GATE) { src = -1; sc = 0.f; }
    else { src = np - (C_GATE - 6472); sc = 1.f; } } };
struct TrDesc { const float* W; bf16* dst; int K, N, nblk, item, map, half; };
__device__ __forceinline__ void tr_map(const TrDesc& d, int np, int& src, float& sc) {
    if (d.map == 0) { src = np; sc = 1.f; }
    else if (d.map == 1) { const int pn = np >> 8, bj = (np >> 7) & 1, c = np & 127; src = bj * d.half + 128 * pn + c; sc = 1.f; }
    else { if (np < 6472) { src = np; sc = (np < 512 || (np >= 1536 && np < 2304) || (np >= 4352 && np < 4864)) ? QSC : 1.f; }
           else if (np < C_GATE) { src = -1; sc = 0.f; }
           else { src = np - (C_GATE - 6472); sc = 1.f; } }
}
__device__ __forceinline__ void tr_load(const TrDesc& d, int lane, f32x4 (&v)[8]) {
    const int kb = d.item / d.nblk, nb = d.item % d.nblk, k0 = 64 * kb, n0 = 32 * nb;
    int src; float sc; tr_map(d, n0 + 4 * (lane & 7), src, sc);
    const GAS float* col = (const GAS float*)d.W + (src < 0 ? 0 : src);
#pragma unroll
    for (int i = 0; i < 8; ++i) { const int kk = 8 * i + (lane >> 3); v[i] = *(const GAS f32x4*)(col + (size_t)(k0 + kk) * d.N); }
}
__device__ __forceinline__ void tr_store(const TrDesc& d, int lane, const f32x4 (&v)[8], LAS float* scr) {
    const int kb = d.item / d.nblk, nb = d.item % d.nblk, k0 = 64 * kb, n0 = 32 * nb;
    int src; float sc; tr_map(d, n0 + 4 * (lane & 7), src, sc);
#pragma unroll
    for (int i = 0; i < 8; ++i) { const int kk = 8 * i + (lane >> 3); f32x4 x = v[i]; if (src < 0) x = (f32x4){0.f, 0.f, 0.f, 0.f}; x = x * sc;
        LAS float* q = scr + kk * 33 + 4 * (lane & 7); q[0] = x.x; q[1] = x.y; q[2] = x.z; q[3] = x.w; }
    LDS_WAIT(); asm volatile("" ::: "memory");
    const int c = lane & 7;
#pragma unroll
    for (int j = 0; j < 4; ++j) { const int n = (lane >> 3) + 8 * j; const LAS float* s = scr + (8 * c) * 33 + n;
        v4u o; o.x = pk2(s[0 * 33], s[1 * 33]); o.y = pk2(s[2 * 33], s[3 * 33]); o.z = pk2(s[4 * 33], s[5 * 33]); o.w = pk2(s[6 * 33], s[7 * 33]);
        *(GAS v4u*)(d.dst + (size_t)(n0 + n) * d.K + k0 + 8 * c) = o; }
    LDS_WAIT(); asm volatile("" ::: "memory");
}
struct WPtrs { const float *up1, *dn1, *win, *glu, *sb, *dil, *ssm, *dsa, *wout, *up2, *dn2; };
__device__ __forceinline__ TrDesc tr_decode(const WPtrs& P, bf16* WT, int it) {
    constexpr int I_UP = (D / 64) * (NUP / 32), I_IN = (D / 64) * (NH / 32), I_DN = (DFF / 64) * (D / 32), I_B5 = (512 / 64) * (D / 32), I_B2 = (256 / 64) * (D / 32), I_OUT = (D / 64) * (D / 32);
    int r = it;
    if (r < I_UP) return TrDesc{P.up1, WT + W_1U, D, NUP, NUP / 32, r, 1, DFF}; r -= I_UP;
    if (r < I_UP) return TrDesc{P.up2, WT + W_2U, D, NUP, NUP / 32, r, 1, DFF}; r -= I_UP;
    if (r < I_IN) return TrDesc{P.win, WT + W_IN, D, INC, NH / 32, r, 2, 0}; r -= I_IN;
    if (r < I_DN) return TrDesc{P.dn1, WT + W_1D, DFF, D, D / 32, r, 0, 0}; r -= I_DN;
    if (r < I_DN) return TrDesc{P.dn2, WT + W_2D, DFF, D, D / 32, r, 0, 0}; r -= I_DN;
    if (r < I_OUT) return TrDesc{P.wout, WT + W_OUT, D, D, D / 32, r, 0, 0}; r -= I_OUT;
    if (r < I_B5) return TrDesc{P.sb, WT + W_SB, 512, D, D / 32, r, 0, 0}; r -= I_B5;
    if (r < I_B5) return TrDesc{P.ssm, WT + W_SSM, 512, D, D / 32, r, 0, 0}; r -= I_B5;
    if (r < I_B5) return TrDesc{P.dsa, WT + W_DSA, 512, D, D / 32, r, 0, 0}; r -= I_B5;
    if (r < I_B2) return TrDesc{P.dil, WT + W_DIL, 256, D, D / 32, r, 0, 0}; r -= I_B2;
    return TrDesc{P.glu, WT + W_GLU, 512, 1024, 1024 / 32, r, 1, 512};
}
__device__ __forceinline__ void weights_phase(const Frame& F, const WPtrs& P, bf16* WT) {
    LAS float* scr = (LAS float*)(F.lds + RING_OFF + F.wave * 16384);
    int gw_ = blockIdx.x * NWAVES + F.wave; asm volatile("" : "+s"(gw_));
    const int gw = gw_, NGW = F.G * NWAVES;
    constexpr int I_UP = (D / 64) * (NUP / 32), I_IN = (D / 64) * (NH / 32), I_DN = (DFF / 64) * (D / 32), I_GLU = (512 / 64) * (1024 / 32), I_B5 = (512 / 64) * (D / 32), I_B2 = (256 / 64) * (D / 32), I_OUT = (D / 64) * (D / 32);
    constexpr int NITEMS = 2 * I_UP + I_IN + 2 * I_DN + I_GLU + 3 * I_B5 + I_B2 + I_OUT;
    if (gw >= NITEMS) return;
    TrDesc cur = tr_decode(P, WT, gw); f32x4 v[8]; tr_load(cur, F.lane, v);
    for (int it = gw; it < NITEMS; it += NGW) {
        const int nit = it + NGW < NITEMS ? it + NGW : it;
        const TrDesc nxt = tr_decode(P, WT, nit); f32x4 nv[8]; tr_load(nxt, F.lane, nv);
        tr_store(cur, F.lane, v, scr);
        cur = nxt;
#pragma unroll
        for (int i = 0; i < 8; ++i) v[i] = nv[i];
    }
}
__device__ __forceinline__ void cast_phase(const Frame& F, const float* x, bf16* xb) {
    const size_t n8 = (size_t)M * D / 8, stride = (size_t)F.G * NWAVES * 64;
    for (size_t i = (size_t)blockIdx.x * NWAVES * 64 + F.tid; i < n8; i += stride) {
        const f32x4 a = ((const GAS f32x4*)x)[2 * i], b = ((const GAS f32x4*)x)[2 * i + 1];
        v4u w; w.x = pk2(a.x, a.y); w.y = pk2(a.z, a.w); w.z = pk2(b.x, b.y); w.w = pk2(b.z, b.w);
        ((GAS v4u*)xb)[i] = w; }
}
__device__ __forceinline__ void ln_phase(const Frame& F, const bf16* yb, float* outf, const float* g, const float* b, bf16* xb, int write_x) {
    const int gw = blockIdx.x * NWAVES + F.wave, NGW = F.G * NWAVES;
    unsigned long long vn[8];
    if (gw < M) { const GAS unsigned long long* x0 = (const GAS unsigned long long*)(yb + (size_t)gw * D) + F.lane;
#pragma unroll
        for (int j = 0; j < 8; ++j) vn[j] = x0[64 * j]; }
    for (int m = gw; m < M; m += NGW) {
        f32x4 v[8]; float s = 0.f;
#pragma unroll
        for (int j = 0; j < 8; ++j) { const unsigned lo = (unsigned)vn[j], hi = (unsigned)(vn[j] >> 32);
            v[j] = (f32x4){__uint_as_float(lo << 16), __uint_as_float(lo & 0xffff0000u), __uint_as_float(hi << 16), __uint_as_float(hi & 0xffff0000u)}; s += (v[j].x + v[j].y) + (v[j].z + v[j].w); }
        { const int mn = (m + NGW < M) ? m + NGW : m; const GAS unsigned long long* xn = (const GAS unsigned long long*)(yb + (size_t)mn * D) + F.lane;
#pragma unroll
          for (int j = 0; j < 8; ++j) vn[j] = xn[64 * j]; }
        const float mean = wave_sum(s) * (1.f / D); float s2 = 0.f;
#pragma unroll
        for (int j = 0; j < 8; ++j) { v[j] = v[j] - mean; s2 += (v[j].x * v[j].x + v[j].y * v[j].y) + (v[j].z * v[j].z + v[j].w * v[j].w); }
        const float rstd = 1.f / sqrtf(wave_sum(s2) * (1.f / D) + LN_EPS);
        GAS f32x4* xr = (GAS f32x4*)(outf + (size_t)m * D) + F.lane;
        GAS unsigned long long* o8 = (GAS unsigned long long*)(xb + (size_t)m * D) + F.lane;
#pragma unroll
        for (int j = 0; j < 8; ++j) { const f32x4 gg = ((const GAS f32x4*)g)[F.lane + 64 * j], bb = ((const GAS f32x4*)b)[F.lane + 64 * j];
            const f32x4 o = v[j] * rstd * gg + bb; if (write_x) xr[64 * j] = o;
            o8[64 * j] = (unsigned long long)pk2(o.x, o.y) | ((unsigned long long)pk2(o.z, o.w) << 32); }
    }
}

struct SsmPtrs { const float *lam_re, *lam_im, *log_dt, *b_re, *b_im, *c_re, *c_im, *dsk; };
__device__ __forceinline__ unsigned fkey(float x) { const unsigned b = __float_as_uint(x); return b ^ ((b >> 31) ? 0xFFFFFFFFu : 0x80000000u); }
typedef short bf16x8v __attribute__((ext_vector_type(8)));
typedef float f32x16 __attribute__((ext_vector_type(16)));
typedef float f32x2t __attribute__((ext_vector_type(2))); typedef __bf16 bf16x2t __attribute__((ext_vector_type(2)));
__device__ __forceinline__ unsigned cvtpk(float lo, float hi) { f32x2t v = {lo, hi}; bf16x2t b = __builtin_convertvector(v, bf16x2t); return __builtin_bit_cast(unsigned, b); }
#define MFMA32(a, b, c) __builtin_amdgcn_mfma_f32_32x32x16_bf16((a), (b), (c), 0, 0, 0)
__device__ __forceinline__ int crow(int r, int hi) { return (r & 3) + 8 * (r >> 2) + 4 * hi; }
__device__ __forceinline__ int pi32(int r) { return (r & 0x13) | ((r & 4) << 1) | ((r & 8) >> 1); }
constexpr int VTP = SEQ;
struct KVF { bf16x8v k[4], v[4]; };
__device__ __forceinline__ f32x16 qk_mma(const KVF& f, const bf16x8v (&qf)[4]) {
    f32x16 sT;
#pragma unroll
    for (int r = 0; r < 16; ++r) sT[r] = 0.f;
#pragma unroll
    for (int st = 0; st < 4; ++st) sT = MFMA32(f.k[st], qf[st], sT);
    return sT;
}
__device__ __forceinline__ void pv_mma_l(const float (&w)[16], const KVF& f, f32x16& O0, f32x16& O1, f32x16& Ol) {
    v4u p0, p1;
    p0.x = cvtpk(w[0], w[1]); p0.y = cvtpk(w[2], w[3]); p0.z = cvtpk(w[4], w[5]); p0.w = cvtpk(w[6], w[7]);
    p1.x = cvtpk(w[8], w[9]); p1.y = cvtpk(w[10], w[11]); p1.z = cvtpk(w[12], w[13]); p1.w = cvtpk(w[14], w[15]);
    const bf16x8v pa0 = __builtin_bit_cast(bf16x8v, p0), pa1 = __builtin_bit_cast(bf16x8v, p1);
    const bf16x8v ones = {0x3F80, 0x3F80, 0x3F80, 0x3F80, 0x3F80, 0x3F80, 0x3F80, 0x3F80};
    O0 = MFMA32(pa0, f.v[0], O0); O0 = MFMA32(pa1, f.v[1], O0);
    O1 = MFMA32(pa0, f.v[2], O1); O1 = MFMA32(pa1, f.v[3], O1);
    Ol = MFMA32(pa0, ones, Ol); Ol = MFMA32(pa1, ones, Ol);
}
__device__ __forceinline__ void pv_mma(const float (&w)[16], const KVF& f, f32x16& O0, f32x16& O1) {
    v4u p0, p1;
    p0.x = cvtpk(w[0], w[1]); p0.y = cvtpk(w[2], w[3]); p0.z = cvtpk(w[4], w[5]); p0.w = cvtpk(w[6], w[7]);
    p1.x = cvtpk(w[8], w[9]); p1.y = cvtpk(w[10], w[11]); p1.z = cvtpk(w[12], w[13]); p1.w = cvtpk(w[14], w[15]);
    const bf16x8v pa0 = __builtin_bit_cast(bf16x8v, p0), pa1 = __builtin_bit_cast(bf16x8v, p1);
    O0 = MFMA32(pa0, f.v[0], O0); O0 = MFMA32(pa1, f.v[1], O0);
    O1 = MFMA32(pa0, f.v[2], O1); O1 = MFMA32(pa1, f.v[3], O1);
}
struct KVG { v4u k[4], v[4]; };
constexpr int KV_KROW = 144, KV_VROW = 80, KV_V_OFF = 32 * KV_KROW, KV_BYTES = KV_V_OFF + 64 * KV_VROW;
__device__ __forceinline__ void kvg_load(KVG& g, const bf16* ktile  , size_t krow_stride  , const bf16* vtile  , int lane) {
#pragma unroll
    for (int j = 0; j < 4; ++j) g.k[j] = *(const GAS v4u*)(ktile + (size_t)((lane >> 3) + 8 * j) * krow_stride + 8 * (lane & 7));
#pragma unroll
    for (int j = 0; j < 4; ++j) g.v[j] = *(const GAS v4u*)(vtile + (size_t)((lane >> 2) + 16 * j) * VTP + 8 * (lane & 3));
}
__device__ __forceinline__ void kvg_store(const KVG& g, LAS unsigned char* img, int lane) {
#pragma unroll
    for (int j = 0; j < 4; ++j) *(LAS v4u*)(img + ((lane >> 3) + 8 * j) * KV_KROW + 16 * (lane & 7)) = g.k[j];
#pragma unroll
    for (int j = 0; j < 4; ++j) *(LAS v4u*)(img + KV_V_OFF + ((lane >> 2) + 16 * j) * KV_VROW + 16 * (lane & 3)) = g.v[j];
}
__device__ __forceinline__ void kvf_read(KVF& f, const LAS unsigned char* img, int n, int hi) {
    const LAS unsigned char* kp = img + pi32(n) * KV_KROW + 16 * hi;
#pragma unroll
    for (int st = 0; st < 4; ++st) f.k[st] = *(const LAS bf16x8v*)(kp + 32 * st);
    const LAS unsigned char* vp = img + KV_V_OFF + n * KV_VROW + 16 * hi;
#pragma unroll
    for (int db = 0; db < 2; ++db)
#pragma unroll
        for (int s = 0; s < 2; ++s) f.v[2 * db + s] = *(const LAS bf16x8v*)(vp + db * 32 * KV_VROW + 32 * s);
}
__device__ __forceinline__ void sb_mfma(const Frame& F, const bf16* Hc, const bf16* VTS, bf16* Y) {
    const int gw = blockIdx.x * NWAVES + F.wave, NGW = F.G * NWAVES, lane = F.lane, n = lane & 31, hi = lane >> 5;
    LAS unsigned char* img = F.lds + RING_OFF + F.wave * 16384;
    for (int it = gw; it < BC * 8 * 64; it += NGW) {
        const int qt = it & 63, h = (it >> 6) & 7, bl = it >> 9;
        const int q0 = qt * 32, t = q0 + n;
        const bf16* base = Hc + (size_t)bl * SEQ * HP;
        bf16x8v qf[4];
        { const bf16* qp = base + (size_t)t * HP + C_SBQ + h * 64 + 8 * hi;
#pragma unroll
          for (int st = 0; st < 4; ++st) qf[st] = *(const GAS bf16x8v*)(qp + 16 * st); }
        f32x16 O0, O1;
#pragma unroll
        for (int r = 0; r < 16; ++r) { O0[r] = 0.f; O1[r] = 0.f; }
        float R = 0.f;
        const bf16* kt0 = base + C_SBK + h * 64; const bf16* vt0 = VTS + (size_t)((bl * 8 + h) * 64) * VTP;
        { KVG g; kvg_load(g, kt0 + (size_t)(qt * 32) * HP, HP, vt0 + qt * 32, lane); kvg_store(g, img, lane); }
        for (int kt = qt; kt >= 0; --kt) {
            const int k0 = kt * 32;
            KVG g; { const int kn = kt > 0 ? kt - 1 : 0; kvg_load(g, kt0 + (size_t)(kn * 32) * HP, HP, vt0 + kn * 32, lane); }
            KVF cur; kvf_read(cur, img, n, hi);
            const f32x16 sT = qk_mma(cur, qf);
            float L[16], w[16];
#pragma unroll
            for (int r = 0; r < 16; ++r) { const int key = k0 + (r & 7) + 8 * hi + 16 * (r >> 3); const float z = sT[r];
                const float sp = fmaxf(z, 0.f) + lg2(1.f + ex2(-fabsf(z))); L[r] = (key < t) ? sp : 0.f; }
            float A0 = 0.f, A1 = 0.f;
#pragma unroll
            for (int r = 0; r < 8; ++r) { A0 += L[r]; A1 += L[8 + r]; }
            const float PA0 = __shfl_xor(A0, 32), PA1 = __shfl_xor(A1, 32);
            { float run = R + (hi ? 0.f : PA1);
#pragma unroll
              for (int r = 15; r >= 8; --r) { const int key = k0 + (r & 7) + 8 * hi + 16; w[r] = (key < t) ? ex2(sT[r] - L[r] - run) : 0.f; run += L[r]; }
              run = R + PA1 + A1 + (hi ? 0.f : PA0);
#pragma unroll
              for (int r = 7; r >= 0; --r) { const int key = k0 + r + 8 * hi; w[r] = (key < t) ? ex2(sT[r] - L[r] - run) : 0.f; run += L[r]; } }
            R += (A0 + A1) + (PA0 + PA1);
            v4u p0, p1;
            p0.x = cvtpk(w[0], w[1]); p0.y = cvtpk(w[2], w[3]); p0.z = cvtpk(w[4], w[5]); p0.w = cvtpk(w[6], w[7]);
            p1.x = cvtpk(w[8], w[9]); p1.y = cvtpk(w[10], w[11]); p1.z = cvtpk(w[12], w[13]); p1.w = cvtpk(w[14], w[15]);
            const bf16x8v pa0 = __builtin_bit_cast(bf16x8v, p0), pa1 = __builtin_bit_cast(bf16x8v, p1);
            O0 = MFMA32(pa0, cur.v[0], O0); O0 = MFMA32(pa1, cur.v[1], O0);
            O1 = MFMA32(pa0, cur.v[2], O1); O1 = MFMA32(pa1, cur.v[3], O1);
            if (__all(R >= 40.f)) break;
            kvg_store(g, img, lane);
        }
        bf16* yp = Y + (size_t)(bl * SEQ + q0) * 512 + h * 64 + n;
#pragma unroll
        for (int r = 0; r < 16; ++r) { bf16* rp = yp + (size_t)crow(r, hi) * 512; rp[0] = (bf16)f2bf(O0[r]); rp[32] = (bf16)f2bf(O1[r]); }
    }
}

__device__ __forceinline__ float row_ref(const f32x16& sT) {
    float a = sT[0];
#pragma unroll
    for (int r = 1; r < 16; ++r) a = fmaxf(a, sT[r]);
    return fmaxf(a, __shfl_xor(a, 32));
}
__device__ __forceinline__ void datt_wg(const Frame& F, const bf16* Hc, const bf16* VTA, const unsigned* MASK32, bf16* Y, const float* rel_bias, LAS float* lut) {
    const int lane = F.lane, n = lane & 31, hi = lane >> 5, w = F.wave, tid = F.tid;
    LAS unsigned char* img0 = F.lds + RING_OFF;
    for (int i = tid; i < 8 * 128; i += NWAVES * 64) lut[i] = rel_bias[t5_bucket(i & 127) * 20 + 12 + (i >> 7)] * LOG2E;
    LDS_WAIT(); __syncthreads();
    const bool kpart = tid < 256; const int u = tid & 255;
    const int src_row = kpart ? (u >> 3) : (u >> 2), src_pc = kpart ? (u & 7) : (u & 3);
    const int dst_off = kpart ? src_row * KV_KROW + 16 * src_pc : KV_V_OFF + src_row * KV_VROW + 16 * src_pc;
    for (int it = blockIdx.x; it < BC * 8 * 4; it += F.G) {
        const int j = it & 3, h = (it >> 2) & 7, bl = it >> 5, qp_ = 8 * j + w;
        const bf16* base = Hc + (size_t)bl * SEQ * HP;
        const LAS float* lh = lut + h * 128;
        const bf16* kt0 = base + C_AK + h * 64; const bf16* vt0 = VTA + (size_t)((bl * 8 + h) * 64) * VTP;
        const bf16* psrc = kpart ? kt0 + (size_t)src_row * HP + 8 * src_pc : vt0 + (size_t)src_row * VTP + 8 * src_pc;
        const size_t pstep = kpart ? (size_t)32 * HP : (size_t)32;
        for (int half = 0; half < 2; ++half) {
            const int qt = half ? 63 - qp_ : qp_, ktmax = half ? 63 - 8 * j : 8 * j + 7, q0 = qt * 32, t = q0 + n;
            bf16x8v qf[4];
            { const bf16* qp = base + (size_t)t * HP + C_AQ + h * 64 + 8 * hi;
#pragma unroll
              for (int st = 0; st < 4; ++st) qf[st] = *(const GAS bf16x8v*)(qp + 16 * st); }
            const unsigned* mrow = MASK32 + (size_t)(bl * SEQ + t) * 64;
            f32x16 O0, O1, Ol;
#pragma unroll
            for (int r = 0; r < 16; ++r) { O0[r] = 0.f; O1[r] = 0.f; Ol[r] = 0.f; }
            { const v4u t0 = *(const GAS v4u*)psrc, t1 = *(const GAS v4u*)(psrc + pstep); *(LAS v4u*)(img0 + dst_off) = t0; *(LAS v4u*)(img0 + 10240 + dst_off) = t1; }
            v4u g1 = *(const GAS v4u*)(psrc + 2 * pstep), g2 = *(const GAS v4u*)(psrc + 3 * pstep);
            unsigned mw = mrow[0];
            LDS_WAIT(); __syncthreads();
            f32x16 sT;
            { KVF c0; const LAS unsigned char* kp = img0 + pi32(n) * KV_KROW + 16 * hi;
#pragma unroll
              for (int st = 0; st < 4; ++st) c0.k[st] = *(const LAS bf16x8v*)(kp + 32 * st);
              sT = qk_mma(c0, qf); }
            const float mref = row_ref(sT);
            int ic = 0, in1 = 10240, in2 = 20480;
            for (int kt = 0; kt <= ktmax; ++kt) {
                const int k0 = kt * 32, k4 = kt + 4 <= ktmax ? kt + 4 : ktmax;
                if (kt) { LDS_WAIT(); __syncthreads(); }
                f32x16 sN;
                if (kt + 1 <= qt) { KVF cn; const LAS unsigned char* kp = img0 + in1 + pi32(n) * KV_KROW + 16 * hi;
#pragma unroll
                    for (int st = 0; st < 4; ++st) cn.k[st] = *(const LAS bf16x8v*)(kp + 32 * st);
                    __builtin_amdgcn_sched_barrier(0);
                    sN = qk_mma(cn, qf); }
                if (kt <= qt) {
                    const int kn = kt < qt ? kt + 1 : qt; const unsigned mwn = mrow[kn];
                    KVF cur; { const LAS unsigned char* vp = img0 + ic + KV_V_OFF + n * KV_VROW + 16 * hi;
#pragma unroll
                      for (int db = 0; db < 2; ++db)
#pragma unroll
                          for (int sx = 0; sx < 2; ++sx) cur.v[2 * db + sx] = *(const LAS bf16x8v*)(vp + db * 32 * KV_VROW + 32 * sx); }
                    float wv[16];
                    const unsigned mwh = mw >> (8 * hi);
                    if (k0 + 31 + 113 <= q0) {
                        const float cb = lh[127] - mref;
#pragma unroll
                        for (int r = 0; r < 16; ++r) { const float p = ex2(sT[r] + cb); const unsigned sel = (unsigned)__builtin_amdgcn_sbfe((int)mwh, (r & 7) + 16 * (r >> 3), 1);
                            wv[r] = __uint_as_float(__float_as_uint(p) & sel); }
                    } else {
#pragma unroll
                        for (int r = 0; r < 16; ++r) { const int ko = (r & 7) + 8 * hi + 16 * (r >> 3); int dist = t - (k0 + ko); dist = dist < 0 ? 0 : (dist > 127 ? 127 : dist);
                            const float p = ex2(sT[r] + lh[dist] - mref); wv[r] = ((mwh >> ((r & 7) + 16 * (r >> 3))) & 1u) ? p : 0.f; }
                    }
                    pv_mma_l(wv, cur, O0, O1, Ol);
                    mw = mwn;
                }
                sT = sN;
                *(LAS v4u*)(img0 + in2 + dst_off) = g1; g1 = g2; g2 = *(const GAS v4u*)(psrc + (size_t)k4 * pstep);
                { const int tmp = ic; ic = in1; in1 = in2; in2 = tmp; }
            }
            bf16* yp = Y + (size_t)(bl * SEQ + q0 + 4 * hi) * 512 + h * 64 + n;
#pragma unroll
            for (int r = 0; r < 16; ++r) { const int ro = (r & 3) + 8 * (r >> 2); const float rr = 1.f / Ol[r]; bf16* rp = yp + (size_t)ro * 512; rp[0] = (bf16)f2bf(O0[r] * rr); rp[32] = (bf16)f2bf(O1[r] * rr); }
            LDS_WAIT(); __syncthreads();
        }
    }
    __syncthreads();
}

constexpr int DILP = 68;
__device__ __forceinline__ void dil_g0(const Frame& F, const bf16* Hc, const bf16* VTD, float* PART, const float* rel_bias, LAS float* lut) {
    int lane_; asm volatile("v_mbcnt_lo_u32_b32 %0, -1, 0\n\tv_mbcnt_hi_u32_b32 %0, -1, %0" : "=v"(lane_));
    const int gw = blockIdx.x * NWAVES + F.wave, NGW = F.G * NWAVES, lane = lane_, n = lane & 31, hi = lane >> 5;
    LAS unsigned char* img = F.lds + RING_OFF + F.wave * 16384;
    for (int i = F.wave * 64 + lane; i < 4 * 132; i += NWAVES * 64) { const int d = i % 132, gh = i / 132; lut[i] = (d <= 128) ? rel_bias[t5_bucket(d) * 20 + gh] * LOG2E : 0.f; }
    LDS_WAIT(); __syncthreads();
    for (int it = gw; it < BC * 4 * 64; it += NGW) {
        const int qt = it & 63, hs = (it >> 6) & 3, bl = it >> 8, q0 = 32 * qt, t = q0 + n;
        const bf16* base = Hc + (size_t)bl * SEQ * HP;
        f32x16 O0, O1, Ol;
#pragma unroll
        for (int r = 0; r < 16; ++r) { O0[r] = 0.f; O1[r] = 0.f; Ol[r] = 0.f; }
        bf16x8v qf[4];
        { const bf16* qp = base + (size_t)t * HP + C_DQ + hs * 64 + 8 * hi;
#pragma unroll
          for (int st = 0; st < 4; ++st) qf[st] = *(const GAS bf16x8v*)(qp + 16 * st); }
        const bf16* kt0 = base + C_DK + hs * 64; const bf16* vt0 = VTD + (size_t)((bl * 12 + hs) * 64) * VTP;
        const LAS float* lh = lut + hs * 132;
        const int klo = qt >= 4 ? qt - 4 : 0, khi = qt;
        float mref = 0.f;
        { KVG g; kvg_load(g, kt0 + (size_t)(klo * 32) * HP, (size_t)HP, vt0 + klo * 32, lane); kvg_store(g, img, lane); }
        for (int kt = klo; kt <= khi; ++kt) {
            const int k0 = kt * 32;
            KVG g; { const int kn = kt < khi ? kt + 1 : khi; kvg_load(g, kt0 + (size_t)(kn * 32) * HP, (size_t)HP, vt0 + kn * 32, lane); }
            KVF cur; kvf_read(cur, img, n, hi);
            const f32x16 sT = qk_mma(cur, qf);
            if (kt == klo) mref = row_ref(sT);
            float w[16];
#pragma unroll
            for (int r = 0; r < 16; ++r) { const int ko = (r & 7) + 8 * hi + 16 * (r >> 3); const int dist = t - (k0 + ko); const bool valid = (dist >= 0) && (dist <= 128);
                const int dc = dist < 0 ? 0 : (dist > 128 ? 128 : dist);
                const float p = ex2(sT[r] + lh[dc] - mref); w[r] = valid ? p : 0.f; }
            pv_mma_l(w, cur, O0, O1, Ol);
            kvg_store(g, img, lane);
        }
#pragma unroll
        for (int r = 0; r < 16; ++r) { float* rp = PART + ((size_t)(bl * SEQ + q0 + crow(r, hi)) * 4 + hs) * DILP; rp[n] = O0[r]; rp[32 + n] = O1[r]; if (n == 0) rp[64] = Ol[r]; }
        if (hi == 0) PART[((size_t)(bl * SEQ + t) * 4 + hs) * DILP + 65] = mref;
    }
    __syncthreads();
}

__device__ __forceinline__ void dil_mfma(const Frame& F, const bf16* Hc, const bf16* VTD, bf16* Y, const float* rel_bias, LAS float* lut, const float* PART) {
    const int gw = blockIdx.x * NWAVES + F.wave, NGW = F.G * NWAVES, lane = F.lane, n = lane & 31, hi = lane >> 5;
    LAS unsigned char* img = F.lds + RING_OFF + F.wave * 16384;
    for (int i = F.tid; i < 12 * 132; i += NWAVES * 64) { const int d = i % 132, gh = i / 132, g = gh >> 2; lut[i] = (d <= 128) ? rel_bias[t5_bucket(d << (2 * g)) * 20 + gh] * LOG2E : 0.f; }
    LDS_WAIT(); __syncthreads();
    for (int it = gw; it < BC * 4 * 16 * 4; it += NGW) {
        const int ib = it & 3, c16 = (it >> 2) & 15, hs = (it >> 6) & 3, bl = it >> 8;
        const bf16* base = Hc + (size_t)bl * SEQ * HP;
        f32x16 O0, O1;
#pragma unroll
        for (int r = 0; r < 16; ++r) { O0[r] = 0.f; O1[r] = 0.f; }
        f32x16 Ol;
#pragma unroll
        for (int r = 0; r < 16; ++r) Ol[r] = 0.f;
        float mref = 0.f; bool first = true;
        for (int g = 2; g >= 1; --g) {
            const int sh = 2 * g, r_ = 1 << sh, head = g * 4 + hs, cls = c16 & (r_ - 1);
            const int pq0 = (c16 >> sh) + (16 >> sh) * 32 * ib, pstep = 16 >> sh;
            const int pq = pq0 + pstep * n, tq = c16 + 16 * (32 * ib + n);
            bf16x8v qf[4];
            { const bf16* qp = base + (size_t)tq * HP + C_DQ + head * 64 + 8 * hi;
#pragma unroll
              for (int st = 0; st < 4; ++st) qf[st] = *(const GAS bf16x8v*)(qp + 16 * st); }
            const bf16* kt0 = base + (size_t)cls * HP + C_DK + head * 64;
            const bf16* vt0 = VTD + (size_t)((bl * 12 + head) * 64) * VTP + cls * (SEQ >> sh);
            const LAS float* lh = lut + head * 132;
            int klo = pq0 - 128; klo = klo < 0 ? 0 : (klo >> 5);
            const int khi = (pq0 + pstep * 31) >> 5;
            { KVG g; kvg_load(g, kt0 + (size_t)(r_ * klo * 32) * HP, (size_t)r_ * HP, vt0 + klo * 32, lane); kvg_store(g, img, lane); }
            for (int kt = klo; kt <= khi; ++kt) {
                const int k0 = kt * 32;
                KVG g; { const int kn = kt < khi ? kt + 1 : khi; kvg_load(g, kt0 + (size_t)(r_ * kn * 32) * HP, (size_t)r_ * HP, vt0 + kn * 32, lane); }
                KVF cur; kvf_read(cur, img, n, hi);
                const f32x16 sT = qk_mma(cur, qf);
                if (first) { mref = row_ref(sT); first = false; }
                float w[16];
#pragma unroll
                for (int r = 0; r < 16; ++r) { const int ko = (r & 7) + 8 * hi + 16 * (r >> 3); const int dist = pq - (k0 + ko); const bool valid = (dist >= 0) && (dist <= 128);
                    const int dc = dist < 0 ? 0 : (dist > 128 ? 128 : dist);
                    const float p = ex2(sT[r] + lh[dc] - mref); w[r] = valid ? p : 0.f; }
                pv_mma_l(w, cur, O0, O1, Ol);
                kvg_store(g, img, lane);
            }
        }
#pragma unroll
        for (int r = 0; r < 16; ++r) { const int jq = crow(r, hi); const float* rp = PART + ((size_t)(bl * SEQ + c16 + 16 * (32 * ib + jq)) * 4 + hs) * DILP;
            const float f = ex2(rp[65] - __shfl(mref, jq)); O0[r] += rp[n] * f; O1[r] += rp[32 + n] * f; Ol[r] += rp[64] * f; }
        bf16* yp = Y + (size_t)(bl * SEQ + c16 + 512 * ib + 64 * hi) * 256 + hs * 64 + n;
#pragma unroll
        for (int r = 0; r < 16; ++r) { const int ro = (r & 3) + 8 * (r >> 2); const float rr = 1.f / Ol[r]; bf16* rp = yp + (size_t)(16 * ro) * 256; rp[0] = (bf16)f2bf(O0[r] * rr); rp[32] = (bf16)f2bf(O1[r] * rr); }
    }
    __syncthreads();
}

__device__ __forceinline__ void dsel_mfma(const Frame& F, const bf16* Hc, unsigned* MASK32, LAS unsigned* part  , LAS unsigned char* qimg  ) {
    const int lane = F.lane, n = lane & 31, hi = lane >> 5, w = F.wave;
    for (int i_ = blockIdx.x * (NWAVES * 64) + F.tid; ; i_ += F.G * NWAVES * 64) { int i = i_; asm volatile("" : "+v"(i)); if (i >= BC * 256 * 8) break;
        const int word = i & 7, t = (i >> 3) & 255, bl = i >> 11; const int nb = t + 1 - 32 * word;
        MASK32[(size_t)(bl * SEQ + t) * 64 + word] = nb >= 32 ? 0xFFFFFFFFu : (nb <= 0 ? 0u : ((1u << nb) - 1u)); }
    int pp = 0; LAS unsigned* hist = (LAS unsigned*)(qimg + 36864);
#define WG_REDUCE(cexpr, out) do { unsigned c_ = (cexpr); c_ += __shfl_xor(c_, 32); if (hi == 0) part[pp * 256 + w * 32 + n] = c_; LDS_WAIT(); __syncthreads(); unsigned t_ = 0; \
        _Pragma("unroll") for (int ww = 0; ww < 8; ++ww) t_ += part[pp * 256 + ww * 32 + n]; out = t_; pp ^= 1; } while (0)
    const bool lpt = (F.G == 256);
    for (int u = blockIdx.x, k = 0; lpt ? (k < 2 && !(k == 1 && (blockIdx.x >> 6) == 0)) : (u < BC * 56); u += F.G, ++k) {
        const int grp = (int)blockIdx.x >> 6, s8 = ((int)blockIdx.x >> 3) & 7;
        const int qt = lpt ? (k == 0 ? 56 - 8 * grp + s8 : 8 * grp + s8) : ((u < 256) ? 63 - (u >> 3) : 8 + ((u - 256) >> 3)), bl = lpt ? ((int)blockIdx.x & 7) : (u & 7);
        const int q0 = 32 * qt, t = q0 + n;
        const bf16* base = Hc + (size_t)bl * SEQ * HP;
        const bf16* qrow = base + (size_t)t * HP;
        const bf16* kb = base + (size_t)pi32(n) * HP + C_IK + 8 * hi;
        const int ntl = ((qt - w) >> 3) + 1;
        __syncthreads();
        for (int i = F.tid; i < 8224 / 4; i += NWAVES * 64) ((LAS v4u*)hist)[i] = (v4u){0u, 0u, 0u, 0u};
        { const int qq = F.tid >> 4, part4 = F.tid & 15; const bf16* src = base + (size_t)(q0 + qq) * HP + C_IQ + part4 * 32; LAS unsigned char* dq = qimg + qq * 1040 + part4 * 64;
#pragma unroll
          for (int k = 0; k < 4; ++k) *(LAS v4u*)(dq + 16 * k) = *(const GAS v4u*)(src + 8 * k); }
        if (F.tid < 32) { int tq = F.tid; asm volatile("" : "+v"(tq)); float wq[8]; ld8(base + (size_t)(q0 + tq) * HP + C_IW, wq); LAS float* wd = (LAS float*)(qimg + 33280) + tq * 9;
#pragma unroll
          for (int k = 0; k < 8; ++k) wd[k] = wq[k]; }
        LDS_WAIT(); __syncthreads();
        const LAS float* wl = (const LAS float*)(qimg + 33280) + n * 9;
        float sc[8][16];
#pragma unroll
        for (int i = 0; i < 8; ++i)
#pragma unroll
            for (int r = 0; r < 16; ++r) sc[i][r] = 0.f;
        const LAS unsigned char* qb = qimg + n * 1040 + 16 * hi;
        bf16x8v kc[4];
#pragma unroll
        for (int st = 0; st < 4; ++st) kc[st] = *(const GAS bf16x8v*)(kb + (size_t)(32 * w) * HP + 16 * st);
#pragma unroll
        for (int i = 0; i < 8; ++i) if (i < ntl) {
            bf16x8v kn[4]; { const int in = (i + 1 < ntl) ? i + 1 : i;
#pragma unroll
              for (int st = 0; st < 4; ++st) kn[st] = *(const GAS bf16x8v*)(kb + (size_t)(32 * (w + 8 * in)) * HP + 16 * st); }
#pragma unroll
            for (int hh = 0; hh < 8; ++hh) {
                f32x16 sT;
#pragma unroll
                for (int r = 0; r < 16; ++r) sT[r] = 0.f;
#pragma unroll
                for (int st = 0; st < 4; ++st) { const bf16x8v qf = *(const LAS bf16x8v*)(qb + hh * 128 + st * 32); sT = MFMA32(kc[st], qf, sT); }
                const float wh = wl[hh];
#pragma unroll
                for (int r = 0; r < 16; ++r) sc[i][r] += wh * fmaxf(sT[r], 0.f);
            }
#pragma unroll
            for (int st = 0; st < 4; ++st) kc[st] = kn[st];
        }
        unsigned key[8][16];
        int pbase = 8 * hi + 32 * w; asm volatile("" : "+v"(pbase));
        const int lim = t - pbase;
#pragma unroll
        for (int i = 0; i < 8; ++i)
#pragma unroll
            for (int r = 0; r < 16; ++r) key[i][r] = (i < ntl && (256 * i + (r & 7) + 16 * (r >> 3)) <= lim) ? fkey(sc[i][r] + 0.f) : 0u;
        unsigned tau = 0u; int above = 0, ceq = 0;
#pragma unroll 1
        for (int ps = 0; ps < 4; ++ps) {
            if (ps == 2 && !__any(ceq > 64)) {
                int nn = n; asm volatile("" : "+v"(nn));
                LAS unsigned* ccnt = part + 1600; LAS unsigned* cres = part + 1632; LAS unsigned short* clist = (LAS unsigned short*)(part + 1728);
                if (w == 0 && hi == 0) ccnt[nn] = 0u;
                LDS_WAIT(); __syncthreads();
#pragma unroll
                for (int i = 0; i < 8; ++i) if (i < ntl) {
#pragma unroll
                    for (int r = 0; r < 16; ++r) { const unsigned k = key[i][r];
                        if ((k >> 16) == tau) { const unsigned slot = __hip_atomic_fetch_add(ccnt + nn, 1u, __ATOMIC_RELAXED, __HIP_MEMORY_SCOPE_WORKGROUP); clist[nn * 64 + (slot & 63u)] = (unsigned short)(k & 0xffffu); } } }
                LDS_WAIT(); __syncthreads();
                const int need16 = 256 - above; const unsigned cn = (unsigned)ceq;
                for (unsigned e = (unsigned)(2 * w + hi); e < cn; e += 16u) { const unsigned v = clist[nn * 64 + e]; int g = 0, q = 0;
                    for (unsigned m = 0; m < cn; ++m) { const unsigned x = clist[nn * 64 + m]; g += (x > v) ? 1 : 0; q += (x == v) ? 1 : 0; }
                    if (g < need16 && need16 <= g + q) { cres[nn] = v; cres[32 + nn] = (unsigned)g; cres[64 + nn] = (unsigned)q; } }
                LDS_WAIT(); __syncthreads();
                tau = (tau << 16) | cres[nn]; above += (int)cres[32 + nn]; ceq = (int)cres[64 + nn];
                break;
            }
            const int s = 24 - 8 * ps; LAS unsigned* hb = hist + (ps & 1) * 8224 + n;
#pragma unroll
            for (int i = 0; i < 8; ++i) if (i < ntl) {
#pragma unroll
                for (int r = 0; r < 16; ++r) { const unsigned k = key[i][r];
                    if (((k >> s) >> 8) == tau) (void)__hip_atomic_fetch_add(hb + ((k >> s) & 255u) * 32, 1u, __ATOMIC_RELAXED, __HIP_MEMORY_SCOPE_WORKGROUP); } }
            LDS_WAIT(); __syncthreads();
            { const int j = 2 * w + hi; unsigned sj = 0u;
#pragma unroll
              for (int b2 = 0; b2 < 16; ++b2) sj += hb[(16 * j + b2) * 32];
              part[j * 32 + n] = sj;
              LAS v4u* hz = (LAS v4u*)(hist + ((ps + 1) & 1) * 8224); for (int i = F.tid; i < 8224 / 4; i += NWAVES * 64) hz[i] = (v4u){0u, 0u, 0u, 0u}; }
            LDS_WAIT(); __syncthreads();
            int cum = above, jsel = 0; bool found = false;
#pragma unroll
            for (int j = 15; j >= 0; --j) { const int h = (int)part[j * 32 + n]; const bool hit = !found && (cum + h >= 256); jsel = hit ? j : jsel; found = found || hit; cum += found ? 0 : h; }
            int chosen = 0, hsel = 0; found = false;
#pragma unroll
            for (int b2 = 15; b2 >= 0; --b2) { const int h = (int)hb[(16 * jsel + b2) * 32]; const bool hit = !found && (cum + h >= 256); chosen = hit ? b2 : chosen; hsel = hit ? h : hsel; found = found || hit; cum += found ? 0 : h; }
            above = cum; ceq = hsel; tau = (tau << 8) | (unsigned)(16 * jsel + chosen);
        }
        const int need = 256 - above;
        unsigned anyw = (unsigned)__any(ceq != need);
        int X = 4096;
        if (anyw) {
            LAS unsigned* tcnt = part + 512; LAS unsigned* tx = part + 544; LAS unsigned short* tlist = (LAS unsigned short*)(part + 576);
            const bool tieq = (ceq != need);
            int nn = n; asm volatile("" : "+v"(nn));
            if (w == 0 && hi == 0) { tcnt[nn] = 0u; tx[nn] = 4096u; }
            LDS_WAIT(); __syncthreads();
            if (tieq) {
#pragma unroll
                for (int i = 0; i < 8; ++i) if (i < ntl) {
#pragma unroll
                    for (int r = 0; r < 16; ++r) if (key[i][r] == tau) { const unsigned slot = __hip_atomic_fetch_add(tcnt + nn, 1u, __ATOMIC_RELAXED, __HIP_MEMORY_SCOPE_WORKGROUP);
                        if (slot < 64u) tlist[nn * 64 + slot] = (unsigned short)(256 * i + (r & 7) + 16 * (r >> 3) + pbase); } } }
            LDS_WAIT(); __syncthreads();
            const unsigned cn = tcnt[nn];
            if (!__any(tieq && cn > 64u)) {
                if (tieq) for (unsigned e = (unsigned)(2 * w + hi); e < cn; e += 16u) { const unsigned pe = tlist[nn * 64 + e]; int rank = 0;
                    for (unsigned m = 0; m < cn; ++m) rank += (tlist[nn * 64 + m] < pe) ? 1 : 0;
                    if (rank == need - 1) tx[nn] = pe + 1u; }
                LDS_WAIT(); __syncthreads();
                X = (int)tx[nn];
            } else {
                X = 0;
                for (int b = 11; b >= 0; --b) {
                    const int Xc = X | (1 << b), Xl = Xc - pbase; unsigned c = 0u;
#pragma unroll
                    for (int i = 0; i < 8; ++i) if (i < ntl) {
#pragma unroll
                        for (int r = 0; r < 16; ++r) c += (key[i][r] == tau && (256 * i + (r & 7) + 16 * (r >> 3)) < Xl) ? 1u : 0u; }
                    unsigned tot; WG_REDUCE(c, tot);
                    if ((int)tot <= need) X = Xc;
                }
            }
        }
        const int Xf = X - pbase;
#pragma unroll
        for (int i = 0; i < 8; ++i) if (i < ntl) {
            unsigned word = 0u;
#pragma unroll
            for (int r = 0; r < 16; ++r) { const bool sel = (key[i][r] > tau) || (key[i][r] == tau && (256 * i + (r & 7) + 16 * (r >> 3)) < Xf); word |= sel ? (1u << ((r & 7) + 16 * (r >> 3))) : 0u; }
            word <<= 8 * hi;
            word |= __shfl_xor(word, 32);
            if (hi == 0) MASK32[(size_t)(bl * SEQ + t) * 64 + (w + 8 * i)] = word;
        }
    }
#undef WG_REDUCE
}

constexpr size_t SSM_APOW = 0, SSM_BT = 576 * 1024, SSM_KT = 832 * 1024, SSM_GT = 2 * MiB, SSM_HT = 6 * MiB;
typedef float f32x2v __attribute__((ext_vector_type(2)));
__device__ __forceinline__ void apow_phase(const Frame& F, const SsmPtrs& S, unsigned char* T) {
    f32x2v* APOW = (f32x2v*)(T + SSM_APOW); f32x2v* BT = (f32x2v*)(T + SSM_BT);
    const int gtid = blockIdx.x * (NWAVES * 64) + F.tid, NT = F.G * NWAVES * 64;
    for (int e = gtid; e < 32 * 33 * 64; e += NT) { const int p = e & 63, k = (e >> 6) % 33, g = e / (33 * 64);
        const float lr = S.lam_re[g * 64 + p], li = S.lam_im[g * 64 + p], dt = expf(S.log_dt[g]);
        const float mag = expf((float)k * (lr * dt)), ang = (float)k * (li * dt); APOW[e] = (f32x2v){mag * cosf(ang), mag * sinf(ang)}; }
    for (int e = gtid; e < 32 * 64 * 16; e += NT) { const int p = (e >> 4) & 63, g = e >> 10;
        const float lr = S.lam_re[g * 64 + p], li = S.lam_im[g * 64 + p], dt = expf(S.log_dt[g]);
        const float mag = expf(lr * dt), a_re = mag * cosf(li * dt), a_im = mag * sinf(li * dt);
        const float den = lr * lr + li * li, f_re = ((a_re - 1.f) * lr + a_im * li) / den, f_im = (a_im * lr - (a_re - 1.f) * li) / den;
        const float br = S.b_re[e], bi = S.b_im[e]; BT[e] = (f32x2v){f_re * br - f_im * bi, f_re * bi + f_im * br}; }
}
__device__ __forceinline__ void ssm_tables_phase(const Frame& F, const SsmPtrs& S, unsigned char* T) {
    const f32x2v* APOW = (const f32x2v*)(T + SSM_APOW); const f32x2v* BT = (const f32x2v*)(T + SSM_BT);
    bf16* KT = (bf16*)(T + SSM_KT); bf16* GT = (bf16*)(T + SSM_GT); bf16* HT = (bf16*)(T + SSM_HT);
    const int gtid = blockIdx.x * (NWAVES * 64) + F.tid, NT = F.G * NWAVES * 64;
    for (int e = gtid; e < 32 * 32 * 128 * 16; e += NT) {
        const int c = e & 15, pp = (e >> 4) & 127, sig = (e >> 11) & 31, g = e >> 16, p = pp & 63;
        const f32x2v ap = APOW[(g * 33 + (31 - sig)) * 64 + p], bt = BT[(g * 64 + p) * 16 + c];
        GT[e] = (bf16)f2bf((pp >> 6) ? (ap.x * bt.y + ap.y * bt.x) : (ap.x * bt.x - ap.y * bt.y)); }
    for (int e = gtid; e < 32 * 32 * 16 * 128; e += NT) {
        const int k = e & 127, c = (e >> 7) & 15, tau = (e >> 11) & 31, g = e >> 16, p = k & 63;
        const f32x2v ap = APOW[(g * 33 + tau + 1) * 64 + p]; const float cr = S.c_re[(g * 16 + c) * 64 + p], ci = S.c_im[(g * 16 + c) * 64 + p];
        HT[e] = (bf16)f2bf((k >> 6) ? -(cr * ap.y + ci * ap.x) : (cr * ap.x - ci * ap.y)); }
    for (int e = gtid; e < 32 * 32 * 16 * 16; e += NT) {
        const int c2 = e & 15, c = (e >> 4) & 15, k = (e >> 8) & 31, g = e >> 13; float acc = 0.f;
        for (int p = 0; p < 64; ++p) { const f32x2v ap = APOW[(g * 33 + k) * 64 + p], bt = BT[(g * 64 + p) * 16 + c2]; const float cr = S.c_re[(g * 16 + c) * 64 + p], ci = S.c_im[(g * 16 + c) * 64 + p];
            const float mr = ap.x * bt.x - ap.y * bt.y, mi = ap.x * bt.y + ap.y * bt.x; acc += cr * mr - ci * mi; }
        KT[e] = (bf16)f2bf(acc); }
}
constexpr int SSM_UROW = 1040, SSM_U_OFF = 0, SSM_P_OFF = 64 * SSM_UROW, SSM_PROW = 516, SSM_S_OFF = SSM_P_OFF + 64 * SSM_PROW, SSM_SROW = 272;
static_assert(SSM_S_OFF % 16 == 0 && SSM_S_OFF + 64 * SSM_SROW <= RING_BYTES, "ssm LDS map");
__device__ __forceinline__ void ssm_mfma(const Frame& F, const bf16* Hc, bf16* YG, const float* dskip, const unsigned char* T) {
    const int lane = F.lane, n = lane & 31, hi = lane >> 5, w = F.wave;
    LAS unsigned char* L = F.lds + RING_OFF;
    const f32x2v* APOW = (const f32x2v*)(T + SSM_APOW);
    for (int u = blockIdx.x; u < BC * 32; u += F.G) {
        const int g = u & 31, bl = u >> 5;
        const bf16* KT = (const bf16*)(T + SSM_KT) + (size_t)g * 32 * 256; const bf16* GT = (const bf16*)(T + SSM_GT) + (size_t)g * 65536; const bf16* HT = (const bf16*)(T + SSM_HT) + (size_t)g * 65536;
#pragma unroll
        for (int k = 0; k < 4; ++k) { const int tok = F.tid + 512 * k; const bf16* up = Hc + (size_t)(bl * SEQ + tok) * HP + C_U + 16 * g;
            const v4u a = *(const GAS v4u*)up, b = *(const GAS v4u*)(up + 8); LAS unsigned char* d = L + SSM_U_OFF + (tok >> 5) * SSM_UROW + (tok & 31) * 32;
            *(LAS v4u*)d = a; *(LAS v4u*)(d + 16) = b; }
        const v4u kt0 = *(const GAS v4u*)(KT + F.tid * 16), kt1 = *(const GAS v4u*)(KT + F.tid * 16 + 8);
        const bf16* gp = GT + (size_t)(32 * (w >> 1) + n) * 16 + 8 * hi;
        bf16x8v ga[16];
#pragma unroll
        for (int k = 0; k < 16; ++k) ga[k] = *(const GAS bf16x8v*)(gp + (size_t)k * 2048);
        LDS_WAIT(); __syncthreads();
        { const int rt = w >> 1, ct = w & 1; f32x16 acc;
#pragma unroll
          for (int r = 0; r < 16; ++r) acc[r] = 0.f;
          const LAS unsigned char* ub = L + SSM_U_OFF + (32 * ct + n) * SSM_UROW + 16 * hi;
          bf16x8v gb[16];
#pragma unroll
          for (int k = 0; k < 16; ++k) gb[k] = *(const GAS bf16x8v*)(gp + (size_t)(16 + k) * 2048);
          __builtin_amdgcn_sched_barrier(0);
#pragma unroll
          for (int k = 0; k < 16; ++k) { const bf16x8v b = *(const LAS bf16x8v*)(ub + k * 32); acc = MFMA32(ga[k], b, acc); }
#pragma unroll
          for (int k = 0; k < 16; ++k) { const bf16x8v b = *(const LAS bf16x8v*)(ub + (16 + k) * 32); acc = MFMA32(gb[k], b, acc); }
          LAS float* pl = (LAS float*)(L + SSM_P_OFF + (32 * ct + n) * SSM_PROW) + 32 * rt;
#pragma unroll
          for (int r = 0; r < 16; ++r) pl[crow(r, hi)] = acc[r]; }
        LDS_WAIT(); __syncthreads();
        if (w == 0) { const f32x2v a32 = APOW[(g * 33 + 32) * 64 + lane]; float sr = 0.f, si = 0.f;
#pragma unroll 1
            for (int jb = 0; jb < 64; jb += 16) { float pr[16], pi[16];
#pragma unroll
                for (int k = 0; k < 16; ++k) { const LAS float* pl = (const LAS float*)(L + SSM_P_OFF + (jb + k) * SSM_PROW); pr[k] = pl[lane]; pi[k] = pl[64 + lane]; }
#pragma unroll
                for (int k = 0; k < 16; ++k) { LAS bf16* sl = (LAS bf16*)(L + SSM_S_OFF + (jb + k) * SSM_SROW); sl[lane] = (bf16)f2bf(sr); sl[64 + lane] = (bf16)f2bf(si);
                    const float nr = a32.x * sr - a32.y * si + pr[k], ni = a32.x * si + a32.y * sr + pi[k]; sr = nr; si = ni; } } }
        LDS_WAIT(); __syncthreads();
        { LAS unsigned char* kd = L + SSM_P_OFF + F.tid * 32; *(LAS v4u*)kd = kt0; *(LAS v4u*)(kd + 16) = kt1; }
        LDS_WAIT(); __syncthreads();
#pragma unroll 1
        for (int q = 0; q < 4; ++q) {
            const int rt = (q < 2) ? w : 15 - w, ct = q & 1; f32x16 acc;
#pragma unroll
            for (int r = 0; r < 16; ++r) acc[r] = 0.f;
            const int tl = 2 * rt + (n >> 4), cl = n & 15;
            const LAS unsigned char* ub = L + SSM_U_OFF + (32 * ct + n) * SSM_UROW + 16 * hi;
            const bf16* hp = HT + (size_t)(tl * 16 + cl) * 128 + 8 * hi; const LAS unsigned char* sb = L + SSM_S_OFF + (32 * ct + n) * SSM_SROW + 16 * hi;
            bf16x8v ha[8];
#pragma unroll
            for (int ks = 0; ks < 8; ++ks) ha[ks] = *(const GAS bf16x8v*)(hp + 16 * ks);
            const LAS unsigned char* kp = L + SSM_P_OFF + cl * 32 + 16 * hi;
            for (int sig = 0; sig <= 2 * rt + 1; sig += 2) {
                const int lag0 = tl - sig, lag1 = lag0 - 1;
                bf16x8v a0 = *(const LAS bf16x8v*)(kp + (lag0 < 0 ? 0 : lag0) * 512), a1 = *(const LAS bf16x8v*)(kp + (lag1 < 0 ? 0 : lag1) * 512);
                if (lag0 < 0) a0 = (bf16x8v){0, 0, 0, 0, 0, 0, 0, 0};
                if (lag1 < 0) a1 = (bf16x8v){0, 0, 0, 0, 0, 0, 0, 0};
                const bf16x8v b0 = *(const LAS bf16x8v*)(ub + sig * 32), b1 = *(const LAS bf16x8v*)(ub + sig * 32 + 32); acc = MFMA32(a0, b0, acc); acc = MFMA32(a1, b1, acc); }
#pragma unroll
            for (int ks = 0; ks < 8; ++ks) { const bf16x8v b = *(const LAS bf16x8v*)(sb + 32 * ks); acc = MFMA32(ha[ks], b, acc); }
            const f32x4 d0 = *(const GAS f32x4*)(dskip + 16 * g + 4 * hi), d1 = *(const GAS f32x4*)(dskip + 16 * g + 8 + 4 * hi);
            const LAS unsigned short* uimg = (const LAS unsigned short*)(L + SSM_U_OFF + (32 * ct + n) * SSM_UROW);
#pragma unroll
            for (int half = 0; half < 2; ++half)
#pragma unroll
                for (int cq = 0; cq < 2; ++cq) {
                    float o[4];
#pragma unroll
                    for (int i = 0; i < 4; ++i) { const int r = 8 * half + 4 * cq + i; const int tau = 2 * rt + half, c = i + 8 * cq + 4 * hi;
                        const float uu = __uint_as_float((unsigned)uimg[tau * 16 + c] << 16); const float dd = cq ? d1[i] : d0[i];
                        const float y = acc[r] + dd * uu; const float z = 0.7978845608028654f * (y + 0.044715f * y * y * y);
                        const float th = 1.f - 2.f * __builtin_amdgcn_rcpf(1.f + ex2(2.f * LOG2E * z)); o[i] = 0.5f * y * (1.f + th); }
                    const unsigned long long wv = (unsigned long long)pk2(o[0], o[1]) | ((unsigned long long)pk2(o[2], o[3]) << 32);
                    *(GAS unsigned long long*)(YG + (size_t)(bl * SEQ + 32 * (32 * ct + n) + 2 * rt + half) * 512 + 16 * g + 8 * cq + 4 * hi) = wv; }
        }
        LDS_WAIT(); __syncthreads();
    }
}
__device__ __forceinline__ bool stage_enter(Frame& F) { int l_; asm volatile("v_mbcnt_lo_u32_b32 %0, -1, 0\n\tv_mbcnt_hi_u32_b32 %0, -1, %0" : "=v"(l_)); F.lane = l_; F.tid = F.wave * 64 + l_; return true; }
struct Args { const float* in[23]; float* out; unsigned char* ws; int lo, hi, use_bar, pad; };
__global__ void __launch_bounds__(NWAVES * 64, 2) fwd_kernel(Args args) {
    extern __shared__ __attribute__((aligned(16))) unsigned char lds[];
    Frame F;
    F.lds = (LAS unsigned char*)lds; F.tid = threadIdx.x; F.lane = F.tid & 63; F.wave = __builtin_amdgcn_readfirstlane(F.tid >> 6); F.G = gridDim.x;
    volatile LAS unsigned* MISC = (volatile LAS unsigned*)(F.lds + MISC_OFF);
    unsigned char* ws = args.ws;
    gu32* ctl = (gu32*)(ws + WS_CTL);
    for (int u = F.tid; u < (LDS_BYTES - LDSCTL_OFF) / 4; u += NWAVES * 64) ((LAS unsigned*)(F.lds + LDSCTL_OFF))[u] = 0u;
    __syncthreads();
    XcdBarrier bar; bar.bar = (unsigned*)(ctl + CW_BAR); bar.x = 0; bar.st = nullptr;
    if (args.use_bar) bar = xcd_barrier_post((unsigned*)(ctl + CW_BAR), MISC + 8);
    const int lo = args.lo, hi = args.hi;
    int st = 0;
#define STAGE_IF (lo <= st && st < hi && stage_enter(F))
#define STAGE_END_T(ty) do { if (st + 1 < hi) { xcd_barrier(bar); } } while (0)
#define STAGE_END STAGE_END_T(0)
    bf16* WT = (bf16*)(ws + WS_WT); bf16* XB = (bf16*)(ws + WS_XB); bf16* MG = (bf16*)(ws + WS_MG); bf16* HB = (bf16*)(ws + WS_H);
    bf16* YB = (bf16*)(ws + WS_YSB);
    bf16* YSB = (bf16*)(ws + WS_YSB); bf16* YDIL = (bf16*)(ws + WS_YDIL); bf16* YSSM = (bf16*)(ws + WS_YSSM); bf16* YDSA = (bf16*)(ws + WS_YDSA); bf16* YG = (bf16*)(ws + WS_YG);
    unsigned long long* MASK = (unsigned long long*)(ws + WS_MASK);
    bf16* GTL = (bf16*)(ws + WS_GT);
    bf16* VTS = (bf16*)(ws + WS_VTS); bf16* VTD = (bf16*)(ws + WS_VTD); bf16* VTA = (bf16*)(ws + WS_VTA);
    float* X = args.out;
    const float* rel_bias = args.in[6];

    for (int layer = 0; layer < DEPTH; ++layer) {
        if (STAGE_IF) {
            WPtrs P; P.up1 = args.in[3] + (size_t)layer * D * NUP; P.dn1 = args.in[4] + (size_t)layer * DFF * D; P.win = args.in[5] + (size_t)layer * D * INC;
            P.glu = args.in[15] + (size_t)layer * 512 * 1024; P.sb = args.in[16] + (size_t)layer * 512 * D; P.dil = args.in[17] + (size_t)layer * 256 * D; P.ssm = args.in[18] + (size_t)layer * 512 * D;
            P.dsa = args.in[19] + (size_t)layer * 512 * D; P.wout = args.in[20] + (size_t)layer * D * D; P.up2 = args.in[21] + (size_t)layer * D * NUP; P.dn2 = args.in[22] + (size_t)layer * DFF * D;
            weights_phase(F, P, WT);
            { SsmPtrs SP; SP.lam_re = args.in[7] + layer * 2048; SP.lam_im = args.in[8] + layer * 2048; SP.log_dt = args.in[9] + layer * 32; SP.b_re = args.in[10] + layer * 32768; SP.b_im = args.in[11] + layer * 32768;
              SP.c_re = args.in[12] + layer * 32768; SP.c_im = args.in[13] + layer * 32768; SP.dsk = args.in[14] + layer * 512; apow_phase(F, SP, ws + WS_SSMT); }
            if (layer == 0) cast_phase(F, args.in[0], XB);
            STAGE_END_T(0);
        }
        ++st;
        for (int s = 0; s < 3; ++s) {
            if (s != 1) {
                if (STAGE_IF) {
                    pg8::Gemm g{XB, WT + (s == 0 ? W_1U : W_2U), M, NUP, D}; pg8::StaticOrder S; S.init(M, NUP, F.G, (int)blockIdx.x, WGM_UP);
                    pg8::EpiPair<0> E{HB, DFF};
                    pg8::gemm_phase<pg8::EpiPair<0>, pg8::StaticOrder, true, true>(F.lds + RING_OFF, g, S, E, F.tid);
                    STAGE_END_T(1);
                }
                ++st;
            } else {
                for (int c = 0; c < NCH; ++c) {
                    const size_t r0 = (size_t)c * MC;
                    if (STAGE_IF) {
                        pg8::Gemm g{XB + r0 * D, WT + W_IN, MC, NH, D}; pg8::StaticOrder S; S.init(MC, NH, F.G, (int)blockIdx.x, WGM_UP);
                        pg8::EpiH E{HB, HP, GATE_T0, GTL, VTS, VTD, VTA};
                        pg8::gemm_phase<pg8::EpiH, pg8::StaticOrder, true, true>(F.lds + RING_OFF, g, S, E, F.tid);
                        STAGE_END_T(2);
                    }
                    ++st;
                    if (STAGE_IF) {
                        {
                        __syncthreads();
                        ssm_mfma(F, HB, YG, args.in[14] + layer * 512, ws + WS_SSMT); dsel_mfma(F, HB, (unsigned*)MASK, (LAS unsigned*)(F.lds + LDSCTL_OFF + 1024), F.lds + RING_OFF); __syncthreads();
                        dil_g0(F, HB, VTD, (float*)(MG + r0 * D), rel_bias, (LAS float*)(F.lds + LDSCTL_OFF + 9984)); }
                        STAGE_END_T(3);
                    }
                    ++st;
                    if (STAGE_IF) {
                        __syncthreads();
                        { pg8::Gemm g{YG, WT + W_GLU, MC, 1024, 512}; pg8::StaticOrder S; S.init(MC, 1024, F.G, (int)blockIdx.x);
                          pg8::EpiPair<1> E{YSSM, 512};
                          pg8::gemm_phase<pg8::EpiPair<1>, pg8::StaticOrder, true, true>(F.lds + RING_OFF, g, S, E, F.tid); }
                        __syncthreads();
                        {
                        sb_mfma(F, HB, VTS, YSB); dil_mfma(F, HB, VTD, YDIL, rel_bias, (LAS float*)(F.lds + LDSCTL_OFF + 9984), (const float*)(MG + r0 * D)); datt_wg(F, HB, VTA, (const unsigned*)MASK, YDSA, rel_bias, (LAS float*)(F.lds + LDSCTL_OFF + 1024)); }
                        STAGE_END_T(4);
                    }
                    ++st;
                    if (STAGE_IF) {
                        bf16* MGc = MG + r0 * D;
                        { pg8::Gemm g{YSB, WT + W_SB, MC, D, 512}; pg8::StaticOrder S; S.init(MC, D, F.G, (int)blockIdx.x); pg8::EpiGateAcc E{GTL, 0, MGc, D, 1};
                          pg8::gemm_phase<pg8::EpiGateAcc, pg8::StaticOrder, true, true>(F.lds + RING_OFF, g, S, E, F.tid); }
                        __syncthreads();
                        { pg8::Gemm g{YDIL, WT + W_DIL, MC, D, 256}; pg8::StaticOrder S; S.init(MC, D, F.G, (int)blockIdx.x); pg8::EpiGateAcc E{GTL, 1, MGc, D, 0};
                          pg8::gemm_phase<pg8::EpiGateAcc, pg8::StaticOrder, true, true>(F.lds + RING_OFF, g, S, E, F.tid); }
                        __syncthreads();
                        { pg8::Gemm g{YSSM, WT + W_SSM, MC, D, 512}; pg8::StaticOrder S; S.init(MC, D, F.G, (int)blockIdx.x); pg8::EpiGateAcc E{GTL, 2, MGc, D, 0};
                          pg8::gemm_phase<pg8::EpiGateAcc, pg8::StaticOrder, true, true>(F.lds + RING_OFF, g, S, E, F.tid); }
                        __syncthreads();
                        { pg8::Gemm g{YDSA, WT + W_DSA, MC, D, 512}; pg8::StaticOrder S; S.init(MC, D, F.G, (int)blockIdx.x); pg8::EpiGateAcc E{GTL, 3, MGc, D, 0};
                          pg8::gemm_phase<pg8::EpiGateAcc, pg8::StaticOrder, true, true>(F.lds + RING_OFF, g, S, E, F.tid); }
                        STAGE_END_T(5);
                    }
                    ++st;
                }
            }
            if (STAGE_IF) {
                const bf16* A = (s == 1) ? MG : HB; const bf16* Bt = WT + (s == 0 ? W_1D : (s == 1 ? W_OUT : W_2D)); const int K = (s == 1) ? D : DFF;
                pg8::Gemm g{A, Bt, M, D, K}; pg8::StaticOrder S; S.init(M, D, F.G, (int)blockIdx.x);
                { pg8::EpiResidC E{XB, YB, D, DN_ALPHA, (s == 1) ? 1.0f : 0.5f};
                  pg8::gemm_phase<pg8::EpiResidC, pg8::StaticOrder, true, true>(F.lds + RING_OFF, g, S, E, F.tid); }
                STAGE_END_T(s == 1 ? 7 : 6);
            }
            ++st;
            if (STAGE_IF) {
                ln_phase(F, YB, X, args.in[1] + (size_t)(layer * 3 + s) * D, args.in[2] + (size_t)(layer * 3 + s) * D, XB, (layer == DEPTH - 1 && s == 2) ? 1 : 0);
                if (s == 0) { SsmPtrs SP; SP.lam_re = args.in[7] + layer * 2048; SP.lam_im = args.in[8] + layer * 2048; SP.log_dt = args.in[9] + layer * 32; SP.b_re = args.in[10] + layer * 32768; SP.b_im = args.in[11] + layer * 32768;
                  SP.c_re = args.in[12] + layer * 32768; SP.c_im = args.in[13] + layer * 32768; SP.dsk = args.in[14] + layer * 512; ssm_tables_phase(F, SP, ws + WS_SSMT); }
                STAGE_END_T(8);
            }
            ++st;
        }
    }
#undef STAGE_IF
#undef STAGE_END
}
constexpr int N_STAGES = DEPTH * 17;

extern "C" void kernel_launch(void* const* d_in, const int* in_sizes, int n_in, void* d_out, int out_size, void* d_ws, size_t ws_size, hipStream_t stream) {
    static int grid = 0;
    if (grid == 0) {
        if (n_in != 23 || in_sizes[0] != M * D || out_size != M * D || ws_size < WS_END) { fprintf(stderr, "kernel_launch: unexpected shapes / workspace (n_in %d, in0 %d, out %d, ws %zu, need %zu)\n", n_in, n_in > 0 ? in_sizes[0] : -1, out_size, ws_size, (size_t)WS_END); grid = -1; return; }
        int dev = 0, cus = 0, per_cu = 0;
        if (hipGetDevice(&dev) != hipSuccess || hipDeviceGetAttribute(&cus, hipDeviceAttributeMultiprocessorCount, dev) != hipSuccess) { grid = -1; return; }
        if (hipFuncSetAttribute((const void*)fwd_kernel, hipFuncAttributeMaxDynamicSharedMemorySize, LDS_BYTES) != hipSuccess) { fprintf(stderr, "kernel_launch: hipFuncSetAttribute failed\n"); grid = -1; return; }
        if (hipOccupancyMaxActiveBlocksPerMultiprocessor(&per_cu, (const void*)fwd_kernel, NWAVES * 64, LDS_BYTES) != hipSuccess || per_cu < 1) fprintf(stderr, "kernel_launch: occupancy query says %d\n", per_cu);
        (void)hipGetLastError();
        grid = cus;
    }
    if (grid < 0) return;
    if (hipMemsetAsync((char*)d_ws + WS_CTL, 0, CTL_ZERO_BYTES, stream) != hipSuccess) return;
    Args a{};
    for (int i = 0; i < 23; ++i) a.in[i] = (const float*)d_in[i];
    a.out = (float*)d_out; a.ws = (unsigned char*)d_ws; a.pad = 0;
#if MK_ONE_LAUNCH
    a.lo = 0; a.hi = N_STAGES; a.use_bar = 1;
    hipLaunchKernelGGL(fwd_kernel, dim3(grid), dim3(NWAVES * 64), LDS_BYTES, stream, a);
#else
    for (int s = 0; s < N_STAGES; ++s) { a.lo = s; a.hi = s + 1; a.use_bar = 0; hipLaunchKernelGGL(fwd_kernel, dim3(grid), dim3(NWAVES * 64), LDS_BYTES, stream, a); }
#endif
}
```
